# Optimizing an MI355X kernel written in HIP

```python
import math
import jax, jax.numpy as jnp
from jax import lax
import numpy as np

D_MODEL = 1024
BATCH = 8
SEQ = 8192
DEPTH = 1

ATTN_HEADS = 8
ATTN_KV_HEADS = 2
ATTN_HEAD_DIM = 64
Q_PER_KV = ATTN_HEADS // ATTN_KV_HEADS
WINDOW = 128
ATTN_BLOCK = WINDOW
ATTN_WIDTH = ATTN_HEADS * ATTN_HEAD_DIM
KV_WIDTH = ATTN_KV_HEADS * ATTN_HEAD_DIM
HGRN_HEADS = 4
HGRN_KEY_DIM = 128
HGRN_VAL_DIM = 128
HGRN_WIDTH = HGRN_HEADS * HGRN_VAL_DIM
HGRN_KEY_WIDTH = HGRN_HEADS * HGRN_KEY_DIM
HGRN_CHUNK = 32
MIX_WIDTH = ATTN_WIDTH + HGRN_WIDTH
IN_SPLITS = [ATTN_WIDTH, KV_WIDTH, KV_WIDTH, HGRN_KEY_WIDTH, HGRN_KEY_WIDTH, HGRN_WIDTH, HGRN_WIDTH]
IN_WIDTH = sum(IN_SPLITS)
N_GROUPS = 4
EXPERTS_PER_GROUP = 8
N_EXPERTS = N_GROUPS * EXPERTS_PER_GROUP
TOP_K = 2
EXPERT_FF = D_MODEL // 4

NORM_EPS = 1e-6
NEG_INF = -1e30

kernel_name = "hymba_swa_sink_hgrn2_hmoe_layer"


def rmsnorm(x, g):
    xf = x.astype(jnp.float32)
    y = xf * lax.rsqrt(jnp.mean(xf * xf, axis=-1, keepdims=True) + NORM_EPS)
    return (y * g.astype(jnp.float32)).astype(x.dtype)


def swa_sink_alibi(q, k, v, sinks):
    B, T, _ = q.shape
    NB = T // ATTN_BLOCK
    qb = q.reshape(B, NB, ATTN_BLOCK, ATTN_KV_HEADS, Q_PER_KV, ATTN_HEAD_DIM)
    pad = ((0, 0), (ATTN_BLOCK, 0), (0, 0))
    kp = jnp.pad(k, pad).reshape(B, NB + 1, ATTN_BLOCK, ATTN_KV_HEADS, ATTN_HEAD_DIM)
    vp = jnp.pad(v, pad).reshape(B, NB + 1, ATTN_BLOCK, ATTN_KV_HEADS, ATTN_HEAD_DIM)
    kb = jnp.concatenate([kp[:, :-1], kp[:, 1:]], axis=2)
    vb = jnp.concatenate([vp[:, :-1], vp[:, 1:]], axis=2)
    scale = 1.0 / math.sqrt(ATTN_HEAD_DIM)
    s = jnp.einsum('bnqgrd,bnkgd->bngrqk', qb, kb, preferred_element_type=jnp.float32) * scale
    qi = jnp.arange(ATTN_BLOCK)[:, None]
    kj = jnp.arange(2 * ATTN_BLOCK)[None, :]
    dist = qi + ATTN_BLOCK - kj
    in_win = (dist >= 0) & (dist < WINDOW)
    not_pad = (jnp.arange(NB)[:, None, None] > 0) | (kj >= ATTN_BLOCK)[None]
    valid = in_win[None] & not_pad
    slopes = jnp.exp2(-8.0 * (jnp.arange(ATTN_HEADS, dtype=jnp.float32) + 1.0) / ATTN_HEADS)
    slopes = slopes.reshape(ATTN_KV_HEADS, Q_PER_KV)[:, :, None, None]
    s = s - slopes * dist.astype(jnp.float32)
    s = jnp.where(valid[None, :, None, None], s, NEG_INF)
    sink = sinks.astype(jnp.float32).reshape(ATTN_KV_HEADS, Q_PER_KV)[:, :, None, None]
    m = jnp.maximum(jnp.max(s, axis=-1, keepdims=True), sink)
    p = jnp.exp(s - m)
    p = p / (jnp.sum(p, axis=-1, keepdims=True) + jnp.exp(sink - m))
    o = jnp.einsum('bngrqk,bnkgd->bnqgrd', p.astype(v.dtype), vb)
    return o.reshape(B, T, ATTN_WIDTH)


def hgrn2(q_raw, f_raw, i_raw, lb):
    B, T, _ = q_raw.shape
    NC = T // HGRN_CHUNK
    shp_k = (B, NC, HGRN_CHUNK, HGRN_HEADS, HGRN_KEY_DIM)
    q = jax.nn.silu(q_raw.astype(jnp.float32)).reshape(shp_k)
    lbf = lb.astype(jnp.float32)
    f = lbf + (1.0 - lbf) * jax.nn.sigmoid(f_raw.astype(jnp.float32))
    k = (1.0 - f).reshape(shp_k)
    logf = jnp.log(f).reshape(shp_k)
    v = i_raw.astype(jnp.float32).reshape(B, NC, HGRN_CHUNK, HGRN_HEADS, HGRN_VAL_DIM)
    b = jnp.cumsum(logf, axis=2)
    b_last = b[:, :, -1:]
    q_dec = q * jnp.exp(b)
    k_dec = k * jnp.exp(-b)
    k_end = k * jnp.exp(b_last - b)
    causal = jnp.tril(jnp.ones((HGRN_CHUNK, HGRN_CHUNK), dtype=bool))
    a = jnp.einsum('bnchk,bnshk->bnhcs', q_dec, k_dec)
    a = jnp.where(causal, a, 0.0)
    o_intra = jnp.einsum('bnhcs,bnshv->bnchv', a, v)

    def step(S, inp):
        qd, ke, vv, decay = inp
        o = jnp.einsum('bchk,bhkv->bchv', qd, S)
        S = S * decay[..., None] + jnp.einsum('bchk,bchv->bhkv', ke, vv)
        return S, o

    S0 = jnp.zeros((B, HGRN_HEADS, HGRN_KEY_DIM, HGRN_VAL_DIM), jnp.float32)
    xs = (jnp.moveaxis(q_dec, 1, 0), jnp.moveaxis(k_end, 1, 0), jnp.moveaxis(v, 1, 0),
          jnp.moveaxis(jnp.exp(b_last[:, :, 0]), 1, 0))
    _, o_inter = lax.scan(step, S0, xs)
    o = o_intra + jnp.moveaxis(o_inter, 0, 1)
    return o.reshape(B, T, HGRN_HEADS, HGRN_VAL_DIM).astype(q_raw.dtype)


def hierarchical_moe(h, w_rg, b_rg, w_re, b_re, w_gate, w_up, w_down):
    B, T, D = h.shape
    tok = h.reshape(-1, D)
    N = tok.shape[0]
    g_prob = jax.nn.softmax((tok @ w_rg + b_rg).astype(jnp.float32), axis=-1)
    g_w, g_idx = lax.top_k(g_prob, 1)
    e_logits = (tok @ w_re + b_re).astype(jnp.float32).reshape(N, N_GROUPS, EXPERTS_PER_GROUP)
    e_sel = e_logits[jnp.arange(N), g_idx[:, 0]]
    e_w, e_idx = lax.top_k(jax.nn.softmax(e_sel, axis=-1), TOP_K)
    e_w = e_w / jnp.sum(e_w, axis=-1, keepdims=True)
    weights = (g_w * e_w).astype(h.dtype)
    expert = (g_idx * EXPERTS_PER_GROUP + e_idx).reshape(-1)
    order = jnp.argsort(expert)
    inv = jnp.argsort(order)
    xs = tok[order // TOP_K]
    sizes = jnp.bincount(expert, length=N_EXPERTS).astype(jnp.int32)
    hg = lax.ragged_dot(xs, w_gate, sizes)
    hu = lax.ragged_dot(xs, w_up, sizes)
    ys = lax.ragged_dot(jax.nn.silu(hg) * hu, w_down, sizes)
    ys = ys[inv].reshape(N, TOP_K, D)
    out = jnp.einsum('nkd,nk->nd', ys, weights)
    return out.reshape(B, T, D)


def setup_inputs(seed: int = 0) -> dict:
    key = jax.random.key(seed)
    ks = jax.random.split(key, 24)
    f32 = jnp.float32
    L, D = DEPTH, D_MODEL

    def nrm(k, shape, scale):
        return jax.random.normal(k, shape, f32) * scale

    return {
        "x": nrm(ks[0], (BATCH, SEQ, D), 1.0),
        "c": nrm(ks[1], (BATCH, D), 1.0),
        "ln1_pre": 1.0 + nrm(ks[2], (L, D), 0.02),
        "ln1_post": 1.0 + nrm(ks[3], (L, D), 0.02),
        "ln2_pre": 1.0 + nrm(ks[4], (L, D), 0.02),
        "ln2_post": 1.0 + nrm(ks[5], (L, D), 0.02),
        "w_ada": nrm(ks[6], (L, D, 6 * D), 0.25 * D ** -0.5),
        "b_ada": nrm(ks[7], (L, 6 * D), 0.01),
        "w_in": nrm(ks[8], (L, D, IN_WIDTH), D ** -0.5),
        "attn_sinks": nrm(ks[9], (L, ATTN_HEADS), 0.5),
        "attn_out_norm": 1.0 + nrm(ks[10], (L, ATTN_WIDTH), 0.02),
        "hgrn_lb": nrm(ks[11], (L + 1, HGRN_KEY_WIDTH), 0.1),
        "hgrn_out_norm": 1.0 + nrm(ks[12], (L, HGRN_WIDTH), 0.02),
        "w_out": nrm(ks[13], (L, MIX_WIDTH, D), MIX_WIDTH ** -0.5),
        "w_router_group": nrm(ks[14], (L, D, N_GROUPS), D ** -0.5),
        "b_router_group": nrm(ks[15], (L, N_GROUPS), 0.01),
        "w_router_expert": nrm(ks[16], (L, D, N_EXPERTS), D ** -0.5),
        "b_router_expert": nrm(ks[17], (L, N_EXPERTS), 0.01),
        "w_exp_gate": nrm(ks[18], (L, N_EXPERTS, D, EXPERT_FF), D ** -0.5),
        "w_exp_up": nrm(ks[19], (L, N_EXPERTS, D, EXPERT_FF), D ** -0.5),
        "w_exp_down": nrm(ks[20], (L, N_EXPERTS, EXPERT_FF, D), EXPERT_FF ** -0.5),
    }


def reference(x, c, ln1_pre, ln1_post, ln2_pre, ln2_post, w_ada, b_ada, w_in, attn_sinks,
              attn_out_norm, hgrn_lb, hgrn_out_norm, w_out, w_router_group, b_router_group,
              w_router_expert, b_router_expert, w_exp_gate, w_exp_up, w_exp_down):
    B, T, D = x.shape
    lb_all = jnp.cumsum(jax.nn.softmax(hgrn_lb.astype(jnp.float32), axis=0), axis=0)
    offsets = list(np.cumsum(IN_SPLITS)[:-1])
    c_act = jax.nn.silu(c)
    for l in range(DEPTH):
        mod = (c_act @ w_ada[l] + b_ada[l])[:, None, :]
        sh1, sc1, ga1, sh2, sc2, ga2 = jnp.split(mod, 6, axis=-1)
        h = rmsnorm(x, ln1_pre[l]) * (1.0 + sc1) + sh1
        proj = h @ w_in[l]
        q_a, k_a, v_a, q_h, f_h, i_h, g_h = jnp.split(proj, offsets, axis=-1)
        attn = rmsnorm(swa_sink_alibi(q_a, k_a, v_a, attn_sinks[l]), attn_out_norm[l])
        hg = hgrn2(q_h, f_h, i_h, lb_all[l])
        hg = rmsnorm(hg, hgrn_out_norm[l].reshape(HGRN_HEADS, HGRN_VAL_DIM)).reshape(B, T, HGRN_WIDTH)
        hg = hg * jax.nn.silu(g_h)
        mix = jnp.concatenate([attn, hg], axis=-1) @ w_out[l]
        x = x + ga1 * rmsnorm(mix, ln1_post[l])
        h = rmsnorm(x, ln2_pre[l]) * (1.0 + sc2) + sh2
        y = hierarchical_moe(h, w_router_group[l], b_router_group[l], w_router_expert[l],
                             b_router_expert[l], w_exp_gate[l], w_exp_up[l], w_exp_down[l])
        x = x + ga2 * rmsnorm(y, ln2_post[l])
    return x
```

```cpp
#include <hip/hip_runtime.h>
#include <cstdio>
#include <cstdint>
#ifndef EPI2
#define EPI2 0
#endif
#ifndef P4DUP
#define P4DUP 0
#endif
__device__ __forceinline__ int lane_id_v() { int l; asm volatile("v_mbcnt_lo_u32_b32 %0, -1, 0\n\tv_mbcnt_hi_u32_b32 %0, -1, %0" : "=v"(l)); return l; }
namespace pg8 {
#define PG8_LAS __attribute__((address_space(3)))
typedef unsigned short bf16_t;
typedef short bf16x8 __attribute__((ext_vector_type(8)));
typedef float f32x4 __attribute__((ext_vector_type(4)));
typedef unsigned u32x4 __attribute__((ext_vector_type(4)));
constexpr int BM = 256, BK = 64, HALF = 128, HTB = HALF * BK * 2  , STAGE_BYTES = 8 * HTB, NXCD = 8, WGM = 8;

__host__ __device__ __forceinline__ int lds_byte(int r, int c) { const int st = (r >> 4) * 2 + (c >> 5), rr = r & 15, cc = c & 31, ob = rr * 64 + cc * 2; return st * 1024 + (ob ^ (((ob >> 9) & 1) << 5)); }
__host__ __device__ __forceinline__ void stage_rc(int b, int& R, int& C) { const int st = b / 1024, sb = b % 1024, swz = sb ^ (((sb >> 9) & 1) << 5); R = (st >> 1) * 16 + swz / 64; C = (st & 1) * 32 + (swz % 64) / 2; }
__host__ __device__ __forceinline__ int perm32(int rho) { const int n = rho >> 4, i = rho & 15; return 8 * (i >> 2) + 4 * n + (i & 3); }

struct Unit { int pm, pn, e, nvalid, lb, j; };
struct Gemm { const bf16_t* A; const bf16_t* Bt; int M, N, K; };

struct StaticOrder {
    int nM, nN, nwg, G, c;
    __host__ __device__ void init(int M, int N, int G_, int c_) { nM = M / BM; nN = N / BM; nwg = nM * nN; G = G_; c = c_; }
    __host__ __device__ bool next(int i, Unit& u) const {
        const long L = (long)i * G + c; if (L >= nwg) return false;
        int wgid = (int)L; { const int q = nwg / NXCD, r = nwg % NXCD, xcd = wgid % NXCD, off = wgid / NXCD; wgid = (xcd < r ? xcd * (q + 1) : r * (q + 1) + (xcd - r) * q) + off; }
        const int nig = WGM * nN, gid = wgid / nig, fm = gid * WGM, gsz = (nM - fm) < WGM ? (nM - fm) : WGM;
        u.pm = fm + ((wgid % nig) % gsz); u.pn = (wgid % nig) / gsz; u.e = 0; u.nvalid = 256; u.lb = 0; u.j = i; return true;
    }
    static constexpr bool FLOW = false;
    __device__ __forceinline__ void wait_ready(const Unit&) const {}
    __device__ __forceinline__ void signal_done(int) const {}
};


__device__ __forceinline__ unsigned cvt_pk_bf16(float lo, float hi) { unsigned r; asm volatile("v_cvt_pk_bf16_f32 %0, %1, %2" : "=v"(r) : "v"(lo), "v"(hi)); return r; }
__device__ __forceinline__ float silu_f(float x) { return x / (1.0f + __expf(-x)); }
struct PlainProb {
    const char* A; const char* Bt; int K;
    __device__ __forceinline__ void a_offs(const Unit& u, const int (&R)[2], const int (&C)[2], unsigned (&o)[2][2]) const {
#pragma unroll
        for (int h = 0; h < 2; ++h)
#pragma unroll
            for (int i = 0; i < 2; ++i) o[h][i] = (unsigned)((u.pm * BM + h * HALF + R[i]) * K + C[i]) * 2u; }
    __device__ __forceinline__ const char* b_ptr(const Unit& u) const { return Bt + (size_t)u.pn * BM * K * 2; }
};
struct GatherProb {
    const char* A; const char* Bt; int K; const PG8_LAS int* tok;
    __device__ __forceinline__ void a_offs(const Unit& u, const int (&R)[2], const int (&C)[2], unsigned (&o)[2][2]) const {
#pragma unroll
        for (int h = 0; h < 2; ++h)
#pragma unroll
            for (int i = 0; i < 2; ++i) o[h][i] = (unsigned)(tok[u.j * BM + h * HALF + R[i]] * K + C[i]) * 2u; }
    __device__ __forceinline__ const char* b_ptr(const Unit& u) const { return Bt + ((size_t)u.e * 512 + (size_t)u.pn * BM) * K * 2; }
};
struct DownProb {
    const char* A; const char* Bt; int K;
    __device__ __forceinline__ void a_offs(const Unit& u, const int (&R)[2], const int (&C)[2], unsigned (&o)[2][2]) const {
#pragma unroll
        for (int h = 0; h < 2; ++h)
#pragma unroll
            for (int i = 0; i < 2; ++i) o[h][i] = (unsigned)((u.pm * BM + h * HALF + R[i]) * K + C[i]) * 2u; }
    __device__ __forceinline__ const char* b_ptr(const Unit& u) const { return Bt + ((size_t)u.e * 1024 + (size_t)u.pn * BM) * K * 2; }
};
struct GroupOrder {
    const PG8_LAS int* pref; const PG8_LAS int* cnt; int npn, G, c, lbstride;
    int Lbase, icut, G2, imax;
    unsigned* flow; int mode  , need, rt0;
    static constexpr bool FLOW = true;
    __device__ __forceinline__ void wait_ready(const Unit& u) const {
        if (mode == 2 && u.pm >= rt0) { while (__hip_atomic_load(flow + u.pm, __ATOMIC_RELAXED, __HIP_MEMORY_SCOPE_AGENT) < (unsigned)need) __builtin_amdgcn_s_sleep(4);
            __builtin_amdgcn_fence(__ATOMIC_ACQUIRE, "agent"); }
    }
    __device__ __forceinline__ void signal_done(int pm) const {
        if (mode == 1) { __builtin_amdgcn_fence(__ATOMIC_RELEASE, "agent"); if (lane_id_v() == 0) __hip_atomic_fetch_add(flow + pm, 1u, __ATOMIC_RELAXED, __HIP_MEMORY_SCOPE_AGENT); }
    }
    __device__ __forceinline__ bool next(int i, Unit& u) const {
        if (i >= imax || (i >= icut && c >= G2)) return false;
        const int L = Lbase + (i < icut ? i * G : icut * G + (i - icut) * G2) + c; const int total = __builtin_amdgcn_readfirstlane(pref[32]) * npn; if (L >= total) return false;
        const int tix = L / npn; u.pn = L - tix * npn; u.pm = tix;
        int e = 0;
        for (int k = 1; k < 32; ++k) e += (tix >= pref[k]) ? 1 : 0;
        e = __builtin_amdgcn_readfirstlane(e);
        const int tile = tix - __builtin_amdgcn_readfirstlane(pref[e]); const int nv = __builtin_amdgcn_readfirstlane(cnt[e]) - tile * BM;
        u.e = e; u.nvalid = nv < BM ? nv : BM; u.lb = e * lbstride + tile * BM; u.j = i; return true;
    }
};
struct EpiBf16S {
    static constexpr bool PERM = true, PERM2 = false; static constexpr int MIN_STORES = 16;
    bf16_t* O; int ldc;
    __device__ __forceinline__ void operator()(const f32x4 (&acc)[2][2][4][2], const Unit& u, int wr, int wc, int fr, int fq) const {
        const int row0 = u.pm * BM + wr * 64 + fr; const int col0 = u.pn * BM + wc * 32 + 8 * fq;
#pragma unroll
        for (int ai = 0; ai < 2; ++ai)
#pragma unroll
            for (int m = 0; m < 4; ++m) { bf16_t* rowp = O + (size_t)(row0 + ai * HALF + m * 16) * ldc + col0;
#pragma unroll
                for (int bj = 0; bj < 2; ++bj) { const f32x4 v0 = acc[ai][bj][m][0], v1 = acc[ai][bj][m][1];
                    u32x4 w; w.x = cvt_pk_bf16(v0[0], v0[1]); w.y = cvt_pk_bf16(v0[2], v0[3]); w.z = cvt_pk_bf16(v1[0], v1[1]); w.w = cvt_pk_bf16(v1[2], v1[3]);
                    *(u32x4*)(rowp + bj * HALF) = w; } }
    }
};

__device__ __forceinline__ int cs_w128(int fr, int fq, int bj) { return fr * 128 + (((2 * fq + bj) ^ (fr & 7)) << 4); }
__device__ __forceinline__ int cs_r128(int lane) { return (lane >> 3) * 128 + (((lane & 7) ^ ((lane >> 3) & 7)) << 4); }
__device__ __forceinline__ int cs_w64(int fr, int fq) { return fr * 64 + ((fq ^ ((fr >> 1) & 3)) << 4); }
__device__ __forceinline__ int cs_r64(int lane) { return (lane >> 2) * 64 + (((lane & 3) ^ ((lane >> 3) & 3)) << 4); }
struct EpiProj {
    static constexpr bool PERM = true, PERM2 = true; static constexpr int MIN_STORES = 16;
    bf16_t* O; int T; size_t ka_off, va_off, xh_off, x_sz; PG8_LAS unsigned char* cs;
    __device__ __forceinline__ void operator()(const f32x4 (&acc)[2][2][4][2], const Unit& u, int wr, int wc, int fr, int fq) const {
        const int lane = fq * 16 + fr, rr = lane >> 3, rc = lane & 7;
        const int bb = (u.pm * BM) / T;
        const int t0 = u.pm * BM - bb * T + wr * 64 + rr;
        const int c = u.pn * BM + wc * 64;
        bf16_t* p; int pitch;
        if (c < 512) { pitch = 64; p = O + (size_t)(bb * 8 + (c >> 6)) * T * 64; }
        else if (c < 768) { pitch = 64; p = O + ((c >= 640) ? va_off : ka_off) + (size_t)(bb * 2 + (((c - 512) >> 6) & 1)) * T * 64; }
        else { const int cc = c - 768; pitch = 128; p = O + xh_off + (size_t)(cc >> 9) * x_sz + (size_t)(cc & 127) + (size_t)(bb * 4 + ((cc >> 7) & 3)) * T * 128; }
        p += (size_t)t0 * pitch + rc * 8;
        PG8_LAS unsigned char* w0p = cs + cs_w128(fr, fq, 0); PG8_LAS unsigned char* w1p = cs + cs_w128(fr, fq, 1); const PG8_LAS unsigned char* rp_ = cs + cs_r128(lane);
        u32x4 r0[3], r1[3];
#pragma unroll
        for (int st = 0; st < 10; ++st) {
            if (st < 8) { const int ai = st >> 2, m = st & 3;
#pragma unroll
                for (int bj = 0; bj < 2; ++bj) { const f32x4 v0 = acc[ai][bj][m][0], v1 = acc[ai][bj][m][1];
                    u32x4 w; w.x = cvt_pk_bf16(v0[0], v0[1]); w.y = cvt_pk_bf16(v0[2], v0[3]); w.z = cvt_pk_bf16(v1[0], v1[1]); w.w = cvt_pk_bf16(v1[2], v1[3]);
                    *(PG8_LAS u32x4*)(bj ? w1p : w0p) = w; }
                r0[st % 3] = *(const PG8_LAS u32x4*)rp_; r1[st % 3] = *(const PG8_LAS u32x4*)(rp_ + 1024); }
            if (st >= 2) { const int so = st - 2, ai = so >> 2, m = so & 3; bf16_t* rp = p + (size_t)((ai * HALF + m * 16) * pitch);
                *(u32x4*)rp = r0[so % 3]; *(u32x4*)(rp + (size_t)(8 * pitch)) = r1[so % 3]; }
        }
    }
};

struct EpiFp8 {
    static constexpr bool PERM = true, PERM2 = true; static constexpr int MIN_STORES = 8;
    unsigned char* O; PG8_LAS unsigned char* cs;
    __device__ __forceinline__ void operator()(const f32x4 (&acc)[2][2][4][2], const Unit& u, int wr, int wc, int fr, int fq) const {
        const int lane = lane_id_v(), rr = lane >> 2, rc = lane & 3;
        unsigned char* p = O + (size_t)(u.pm * BM + wr * 64 + rr) * 1024 + u.pn * BM + wc * 64 + rc * 16;
        PG8_LAS unsigned char* wp = cs + cs_w64(lane & 15, lane >> 4); const PG8_LAS unsigned char* rp_ = cs + cs_r64(lane);
        u32x4 rb[3];
#pragma unroll
        for (int st = 0; st < 10; ++st) {
            if (st < 8) { const int ai = st >> 2, m = st & 3; int w[4];
#pragma unroll
                for (int bj = 0; bj < 2; ++bj) { const f32x4 v0 = acc[ai][bj][m][0] * 16.0f, v1 = acc[ai][bj][m][1] * 16.0f;
                    int w0 = 0, w1 = 0;
                    w0 = __builtin_amdgcn_cvt_pk_fp8_f32(v0[0], v0[1], w0, false); w0 = __builtin_amdgcn_cvt_pk_fp8_f32(v0[2], v0[3], w0, true);
                    w1 = __builtin_amdgcn_cvt_pk_fp8_f32(v1[0], v1[1], w1, false); w1 = __builtin_amdgcn_cvt_pk_fp8_f32(v1[2], v1[3], w1, true);
                    w[2 * bj] = w0; w[2 * bj + 1] = w1; }
                const u32x4 wv = {(unsigned)w[0], (unsigned)w[1], (unsigned)w[2], (unsigned)w[3]};
                *(PG8_LAS u32x4*)wp = wv;
                rb[st % 3] = *(const PG8_LAS u32x4*)rp_; }
            if (st >= 2) { const int so = st - 2, ai = so >> 2, m = so & 3; *(u32x4*)(p + (size_t)(ai * HALF + m * 16) * 1024) = rb[so % 3]; }
        }
    }
};

struct EpiBf16W {
    static constexpr bool PERM = true, PERM2 = true; static constexpr int MIN_STORES = 16;
    bf16_t* O; int ldc; PG8_LAS unsigned char* cs;
    __device__ __forceinline__ void operator()(const f32x4 (&acc)[2][2][4][2], const Unit& u, int wr, int wc, int fr, int fq) const {
        const int lane = fq * 16 + fr, rr = lane >> 3, rc = lane & 7;
        bf16_t* p = O + (size_t)(u.pm * BM + wr * 64 + rr) * ldc + u.pn * BM + wc * 64 + rc * 8;
        PG8_LAS unsigned char* w0p = cs + cs_w128(fr, fq, 0); PG8_LAS unsigned char* w1p = cs + cs_w128(fr, fq, 1); const PG8_LAS unsigned char* rp_ = cs + cs_r128(lane);
        u32x4 r0[3], r1[3];
#pragma unroll
        for (int st = 0; st < 10; ++st) {
            if (st < 8) { const int ai = st >> 2, m = st & 3;
#pragma unroll
                for (int bj = 0; bj < 2; ++bj) { const f32x4 v0 = acc[ai][bj][m][0], v1 = acc[ai][bj][m][1];
                    u32x4 w; w.x = cvt_pk_bf16(v0[0], v0[1]); w.y = cvt_pk_bf16(v0[2], v0[3]); w.z = cvt_pk_bf16(v1[0], v1[1]); w.w = cvt_pk_bf16(v1[2], v1[3]);
                    *(PG8_LAS u32x4*)(bj ? w1p : w0p) = w; }
                r0[st % 3] = *(const PG8_LAS u32x4*)rp_; r1[st % 3] = *(const PG8_LAS u32x4*)(rp_ + 1024); }
            if (st >= 2) { const int so = st - 2, ai = so >> 2, m = so & 3; bf16_t* rowp = p + (size_t)(ai * HALF + m * 16) * ldc;
                *(u32x4*)rowp = r0[so % 3]; *(u32x4*)(rowp + (size_t)8 * ldc) = r1[so % 3]; }
        }
    }
};
struct EpiGateUp {
    static constexpr bool PERM = true, PERM2 = false; static constexpr int MIN_STORES = 8;
    bf16_t* ACT; PG8_LAS unsigned char* cs;
    __device__ __forceinline__ void operator()(const f32x4 (&acc)[2][2][4][2], const Unit& u, int wr, int wc, int fr, int fq) const {
        const int lane = lane_id_v(), rr = lane >> 2, rc = lane & 3;
        bf16_t* p = ACT + (size_t)(u.pm * BM + wr * 64 + rr) * 256 + u.pn * HALF + wc * 32 + rc * 8;
        PG8_LAS unsigned char* wp = cs + cs_w64(lane & 15, lane >> 4); const PG8_LAS unsigned char* rp_ = cs + cs_r64(lane);
        u32x4 rb[3];
#pragma unroll
        for (int st = 0; st < 10; ++st) {
            if (st < 8) { const int ai = st >> 2, m = st & 3;
                const f32x4 g0 = acc[ai][0][m][0], g1 = acc[ai][0][m][1], u0 = acc[ai][1][m][0], u1 = acc[ai][1][m][1];
                u32x4 w; w.x = cvt_pk_bf16(silu_f(g0[0]) * u0[0], silu_f(g0[1]) * u0[1]); w.y = cvt_pk_bf16(silu_f(g0[2]) * u0[2], silu_f(g0[3]) * u0[3]);
                w.z = cvt_pk_bf16(silu_f(g1[0]) * u1[0], silu_f(g1[1]) * u1[1]); w.w = cvt_pk_bf16(silu_f(g1[2]) * u1[2], silu_f(g1[3]) * u1[3]);
                *(PG8_LAS u32x4*)wp = w;
                rb[st % 3] = *(const PG8_LAS u32x4*)rp_; }
            if (st >= 2) { const int so = st - 2, ai = so >> 2, m = so & 3; *(u32x4*)(p + (size_t)(ai * HALF + m * 16) * 256) = rb[so % 3]; }
        }
    }
};
struct EpiDown {
    static constexpr bool PERM = true, PERM2 = false; static constexpr int MIN_STORES = 0;
    bf16_t* Y; const PG8_LAS int* ent;
    __device__ __forceinline__ void operator()(const f32x4 (&acc)[2][2][4][2], const Unit& u, int wr, int wc, int fr, int fq) const {
        const int col0 = u.pn * BM + wc * 32 + 8 * fq;
#pragma unroll
        for (int ai = 0; ai < 2; ++ai)
#pragma unroll
            for (int m = 0; m < 4; ++m) { const int r = ai * HALF + wr * 64 + m * 16 + fr;
                const int dest = ent[(u.j * BM + r) * 2]; const float wt = __builtin_bit_cast(float, ent[(u.j * BM + r) * 2 + 1]);
                if (r < u.nvalid) { bf16_t* rowp = Y + (size_t)dest * 1024 + col0;
#pragma unroll
                    for (int bj = 0; bj < 2; ++bj) { const f32x4 v0 = acc[ai][bj][m][0] * wt, v1 = acc[ai][bj][m][1] * wt;
                        u32x4 w; w.x = cvt_pk_bf16(v0[0], v0[1]); w.y = cvt_pk_bf16(v0[2], v0[3]); w.z = cvt_pk_bf16(v1[0], v1[1]); w.w = cvt_pk_bf16(v1[2], v1[3]);
                        *(u32x4*)(rowp + bj * HALF) = w; } } }
    }
};
template <class Prob, class Epi, class Sched, bool ALIGN_EPI = false, bool POSTEPI = false>
__device__ __forceinline__ void gemm_phase2(PG8_LAS unsigned char* lds, const Prob& P, const Sched& S, const Epi& E, int wid  ) {
    constexpr bool SP2 = true;
    const int lane = lane_id_v(), tid = wid * 64 + lane, wr = wid >> 2, wc = wid & 3, fr = lane & 15, fq = lane >> 4;
    const int K = P.K, nt = K / BK;
    unsigned voffB[2];
#pragma unroll
    for (int i = 0; i < 2; ++i) { int R, C; stage_rc(tid * 16 + i * 8192, R, C);
        int Rb = Epi::PERM ? ((R & ~31) + perm32(R & 31)) : R;
        if (Epi::PERM2) Rb = (R >> 5) * 64 + ((R >> 2) & 3) * 16 + ((R >> 4) & 1) * 4 + (R & 3);
        voffB[i] = (unsigned)(Rb * K + C) * 2u; }
    const unsigned hstepB = Epi::PERM2 ? 8u * K * 2 : (unsigned)HALF * K * 2;
#define PG8_AOFFS(unit, dst) do { int RA_[2], CA_[2]; _Pragma("unroll") for (int i_ = 0; i_ < 2; ++i_) stage_rc(tid * 16 + i_ * 8192, RA_[i_], CA_[i_]); P.a_offs(unit, RA_, CA_, dst); } while (0)
    const unsigned kstep = BK * 2;
    const unsigned ldsw = (unsigned)wid * 1024u;
    const int aoff = lds_byte(wr * 64 + fr, fq * 8), boff = lds_byte(wc * 32 + fr, fq * 8);
#define PG8_SA(b, h) (((b) * 2 + (h)) * HTB)
#define PG8_SB(b, h) ((4 + (b) * 2 + (h)) * HTB)
#define PG8_STAGE(bufoff, RS, soff, voff) do { _Pragma("unroll") for (int _i = 0; _i < 2; ++_i) \
        __builtin_amdgcn_raw_ptr_buffer_load_lds(RS, (PG8_LAS void*)(lds + (bufoff) + ldsw + _i * 8192), 16, (int)(voff)[_i], (int)(soff), 0, 0); } while (0)
#define PG8_STAGE_SEL(bufoff, RS, soff, sel, vA, vB) do { _Pragma("unroll") for (int _i = 0; _i < 2; ++_i) \
        __builtin_amdgcn_raw_ptr_buffer_load_lds(RS, (PG8_LAS void*)(lds + (bufoff) + ldsw + _i * 8192), 16, (int)((sel) ? (vA)[_i] : (vB)[_i]), (int)(soff), 0, 0); } while (0)
#define PG8_LDA(dst, b, h) do { _Pragma("unroll") for (int m = 0; m < 4; ++m) _Pragma("unroll") for (int k = 0; k < 2; ++k) dst[m][k] = *(const PG8_LAS bf16x8*)(lds + PG8_SA(b, h) + aoff + m * 2048 + k * 1024); } while (0)
#define PG8_LDB(dst, b, h) do { _Pragma("unroll") for (int n = 0; n < 2; ++n) _Pragma("unroll") for (int k = 0; k < 2; ++k) dst[n][k] = *(const PG8_LAS bf16x8*)(lds + PG8_SB(b, h) + boff + n * 2048 + k * 1024); } while (0)
#define PG8_MMA(ai, bj, At, Bt) do { __builtin_amdgcn_s_setprio(1); _Pragma("unroll") for (int m = 0; m < 4; ++m) _Pragma("unroll") for (int n = 0; n < 2; ++n) _Pragma("unroll") for (int k = 0; k < 2; ++k) \
        acc[ai][bj][m][n] = __builtin_amdgcn_mfma_f32_16x16x32_bf16(Bt[n][k], At[m][k], acc[ai][bj][m][n], 0, 0, 0); __builtin_amdgcn_s_setprio(0); } while (0)
#define PG8_WAIT_V(n) asm volatile("s_waitcnt vmcnt(" #n ")" ::: "memory")
#define PG8_WAIT_VS(pe) do { if constexpr ((pe) && Epi::MIN_STORES >= 16) PG8_WAIT_V(24); else if constexpr ((pe) && Epi::MIN_STORES >= 8) PG8_WAIT_V(16); else PG8_WAIT_V(8); } while (0)
#define PG8_WAIT_L(n) asm volatile("s_waitcnt lgkmcnt(" #n ")" ::: "memory")
#define PG8_BAR __builtin_amdgcn_s_barrier()
#define PG8_SCHED __builtin_amdgcn_sched_barrier(0)
#define PG8_KITER(TT, PE) do { const int t = (TT); \
            const bool last = (t == nt - 2); \
            const unsigned a1 = (unsigned)(t + 1) * kstep; \
            const unsigned a2 = last ? 0u : (unsigned)(t + 2) * kstep; const unsigned b2 = last ? nB : cB + (unsigned)(t + 2) * kstep; \
            const unsigned a3 = a2 + kstep, b3 = b2 + kstep; \
            { \
            constexpr bool pe = (PE); \
            PG8_LDB(B0, 0, 0); PG8_LDB(B1, 0, 1); PG8_SCHED; PG8_LDA(At, 0, 0); if constexpr (!pe) PG8_STAGE(PG8_SA(1, 1), rA, a1, aoc[1]); \
            PG8_WAIT_VS(pe); PG8_WAIT_L(0); PG8_BAR; PG8_MMA(0, 0, At, B0); PG8_MMA(0, 1, At, B1); PG8_BAR; PG8_SCHED; \
            PG8_LDA(At, 0, 1); PG8_STAGE(PG8_SB(0, 0), rB, b2, voffB); PG8_STAGE(PG8_SB(0, 1), rB, b2 + hstepB, voffB); PG8_STAGE_SEL(PG8_SA(0, 0), rA, a2, last, aon[0], aoc[0]); \
            PG8_WAIT_VS(pe); PG8_WAIT_L(0); PG8_BAR; PG8_MMA(1, 0, At, B0); PG8_MMA(1, 1, At, B1); PG8_BAR; PG8_SCHED; \
            PG8_LDB(B0, 1, 0); PG8_LDB(B1, 1, 1); PG8_SCHED; PG8_LDA(At, 1, 0); PG8_STAGE_SEL(PG8_SA(0, 1), rA, a2, last, aon[1], aoc[1]); \
            PG8_WAIT_VS(pe); PG8_WAIT_L(0); PG8_BAR; PG8_MMA(0, 0, At, B0); PG8_MMA(0, 1, At, B1); PG8_BAR; PG8_SCHED; \
            PG8_LDA(At, 1, 1); PG8_STAGE(PG8_SB(1, 0), rB, b3, voffB); PG8_STAGE(PG8_SB(1, 1), rB, b3 + hstepB, voffB); PG8_STAGE_SEL(PG8_SA(1, 0), rA, a3, last, aon[0], aoc[0]); \
            PG8_WAIT_V(8); PG8_WAIT_L(0); PG8_BAR; PG8_MMA(1, 0, At, B0); PG8_MMA(1, 1, At, B1); PG8_BAR; PG8_SCHED; \
            } \
        } while (0)
    Unit cur, nxt; int ui = 0;
    if (!S.next(0, cur)) return;
    if constexpr (Sched::FLOW) S.wait_ready(cur);
    int prev_pm = -1;
    f32x4 acc[2][2][4][2];
#pragma unroll
    for (int a = 0; a < 2; ++a)
#pragma unroll
        for (int b = 0; b < 2; ++b)
#pragma unroll
            for (int m = 0; m < 4; ++m)
#pragma unroll
                for (int n = 0; n < 2; ++n) acc[a][b][m][n] = (f32x4){0.f, 0.f, 0.f, 0.f};
    bf16x8 At[4][2], B0[2][2], B1[2][2];
    const __amdgpu_buffer_rsrc_t rA = __builtin_amdgcn_make_buffer_rsrc((void*)P.A, (short)0, 0x7fffffff, 0x00020000);
    const __amdgpu_buffer_rsrc_t rB = __builtin_amdgcn_make_buffer_rsrc((void*)P.Bt, (short)0, 0x7fffffff, 0x00020000);
    unsigned cB = (unsigned)(P.b_ptr(cur) - P.Bt);
    unsigned aoc[2][2], aon[2][2]; PG8_AOFFS(cur, aoc);
    if constexpr (SP2) {
        PG8_STAGE(PG8_SB(0, 0), rB, cB, voffB); PG8_STAGE(PG8_SB(0, 1), rB, cB + hstepB, voffB); PG8_STAGE(PG8_SA(0, 0), rA, 0u, aoc[0]); PG8_STAGE(PG8_SA(0, 1), rA, 0u, aoc[1]);
        if (wr == 1) PG8_BAR;
        PG8_WAIT_V(2); PG8_BAR;
        PG8_STAGE(PG8_SB(1, 0), rB, cB + kstep, voffB); PG8_STAGE(PG8_SA(1, 0), rA, kstep, aoc[0]); PG8_STAGE(PG8_SB(1, 1), rB, cB + hstepB + kstep, voffB);
        PG8_WAIT_V(6); PG8_BAR;
    }
    for (;;) {
        const bool has_next = S.next(ui + 1, nxt);
        if constexpr (Sched::FLOW) { if (has_next) S.wait_ready(nxt); }
        const unsigned nB = has_next ? (unsigned)(P.b_ptr(nxt) - P.Bt) : cB;
        if (has_next) PG8_AOFFS(nxt, aon); else { aon[0][0] = aoc[0][0]; aon[0][1] = aoc[0][1]; aon[1][0] = aoc[1][0]; aon[1][1] = aoc[1][1]; }
        if constexpr (POSTEPI) { int t0_ = 0; if (ui > 0) { PG8_KITER(0, true); t0_ = 2; }
          for (int tt_ = t0_; tt_ < nt; tt_ += 2) PG8_KITER(tt_, false); }
        else { for (int tt_ = 0; tt_ < nt; tt_ += 2) PG8_KITER(tt_, false); }
        if constexpr (Sched::FLOW) { if (prev_pm >= 0 && wid == 0) S.signal_done(prev_pm); prev_pm = cur.pm; }
        if constexpr (POSTEPI) PG8_STAGE(PG8_SA(1, 1), rA, kstep, aon[1]);
        if constexpr (ALIGN_EPI) { if (wr == 0) PG8_BAR; }
        E(acc, cur, wr, wc, fr, fq);
#if defined(EPI2) && EPI2
        asm volatile("" ::: "memory"); E(acc, cur, wr, wc, fr, fq);
#endif
        if (!has_next) break;
#pragma unroll
        for (int a = 0; a < 2; ++a)
#pragma unroll
            for (int b = 0; b < 2; ++b)
#pragma unroll
                for (int m = 0; m < 4; ++m)
#pragma unroll
                    for (int n = 0; n < 2; ++n) acc[a][b][m][n] = (f32x4){0.f, 0.f, 0.f, 0.f};
        cur = nxt; cB = nB; ++ui;
        aoc[0][0] = aon[0][0]; aoc[0][1] = aon[0][1]; aoc[1][0] = aon[1][0]; aoc[1][1] = aon[1][1];
        if constexpr (ALIGN_EPI) { if (wr == 1) PG8_BAR; }
    }
    PG8_WAIT_V(0);
    if constexpr (!ALIGN_EPI) { if (wr == 0) PG8_BAR; }
    PG8_BAR;
    if constexpr (Sched::FLOW) { if (wid == 0) S.signal_done(prev_pm); }
#undef PG8_SA
#undef PG8_SB
#undef PG8_STAGE
#undef PG8_STAGE_SEL
#undef PG8_LDA
#undef PG8_LDB
#undef PG8_MMA
#undef PG8_WAIT_V
#undef PG8_WAIT_VS
#undef PG8_AOFFS
#undef PG8_KITER
#undef PG8_WAIT_L
#undef PG8_BAR
#undef PG8_SCHED
}
}
constexpr int NWAVES = 8;
#ifndef MK_N_LAUNCHES
#define MK_N_LAUNCHES 1
#endif
constexpr int N_PHASES = 10;
constexpr int N_LAUNCHES = MK_N_LAUNCHES;
constexpr int BATCH = 8, T = 8192, D = 1024, M = BATCH * T;
constexpr int NPROJ = 2816;
constexpr int OFF_QA = 0, OFF_KA = 512, OFF_VA = 640, OFF_QH = 768, OFF_FH = 1280, OFF_IH = 1792, OFF_GH = 2304;
constexpr int NEXP = 32, FF = 256;
constexpr size_t PJ_QA = 0, PJ_KA = (size_t)M * 512, PJ_VA = (size_t)M * 640, PJ_XH = (size_t)M * 768, PJ_XSZ = (size_t)M * 512;
constexpr float NORM_EPS = 1e-6f;

constexpr size_t MiB = 1u << 20;
constexpr size_t WS_CTL = 0, CTL_ZERO_BYTES = 64 * 1024;
constexpr size_t WS_MOD = 1 * MiB;
constexpr size_t WS_LB = 1 * MiB + 256 * 1024;
constexpr size_t WS_WRT = 2 * MiB;
constexpr size_t WS_TOKPOS = 3 * MiB;
constexpr size_t WS_WIN = 4 * MiB;
constexpr size_t WS_WOUT = 10 * MiB;
constexpr size_t WS_WGU = 12 * MiB;
constexpr size_t WS_WD = 44 * MiB;
constexpr size_t WS_VT = 76 * MiB;
constexpr size_t WS_LIST = 60 * MiB;
constexpr size_t WS_H = 96 * MiB;
constexpr size_t WS_PROJ = 224 * MiB;
constexpr size_t WS_MIXIN = 576 * MiB;
constexpr size_t WS_X1 = 704 * MiB;
constexpr size_t WS_ACT = 832 * MiB;
constexpr size_t WS_Y = WS_PROJ;
constexpr size_t WS_U = 904 * MiB;
constexpr size_t WS_DSEG = 920 * MiB;
constexpr size_t WS_END = 921 * MiB;

constexpr int CW_BAR = 4096;
constexpr int CW_CNT = 8192;
constexpr int CW_FLOW = 8320;
#ifndef FLOWSEAM
#define FLOWSEAM 1
#endif

constexpr int RING_OFF = 0, RING_BYTES = 131072;
constexpr int LDS_BYTES = 163840;
constexpr int LDSCTL_OFF = LDS_BYTES - 1024, MISC_OFF = LDSCTL_OFF + 320;
constexpr int TAB_OFF = RING_BYTES;
constexpr int CS_OFF = TAB_OFF + 8704;
static_assert(CS_OFF + 8 * 2048 <= LDSCTL_OFF, "epilogue staging");
constexpr int P3_LDS_END = LDSCTL_OFF;

#define GAS __attribute__((address_space(1)))
#define LAS __attribute__((address_space(3)))
typedef unsigned short bf16;
typedef unsigned v4u __attribute__((ext_vector_type(4)));
typedef unsigned v2u __attribute__((ext_vector_type(2)));
typedef float f32x4 __attribute__((ext_vector_type(4)));
typedef int v2i __attribute__((ext_vector_type(2)));
typedef short bf16x8 __attribute__((ext_vector_type(8)));
typedef short s16x4 __attribute__((ext_vector_type(4)));
typedef float f32x16 __attribute__((ext_vector_type(16)));
typedef float f32x2_t __attribute__((ext_vector_type(2)));
typedef __bf16 bf16x2_t __attribute__((ext_vector_type(2)));
__device__ __forceinline__ unsigned cvtpk_s(float lo, float hi) { f32x2_t v = {lo, hi}; bf16x2_t b = __builtin_convertvector(v, bf16x2_t); return __builtin_bit_cast(unsigned, b); }
__device__ __forceinline__ int crow32(int r, int hf) { return (r & 3) + 8 * (r >> 2) + 4 * hf; }
typedef short v4i16_t __attribute__((ext_vector_type(4)));
__device__ __forceinline__ s16x4 vtr16(const LAS unsigned char* p) { return __builtin_bit_cast(s16x4, __builtin_amdgcn_ds_read_tr16_b64_v4i16((LAS v4i16_t*)p)); }
typedef GAS unsigned gu32;
#define RLX_AGENT __ATOMIC_RELAXED, __HIP_MEMORY_SCOPE_AGENT
#define LDS_WAIT() asm volatile("s_waitcnt lgkmcnt(0)" ::: "memory")
__device__ __forceinline__ unsigned f2bf(float f) { unsigned u = __builtin_bit_cast(unsigned, f); return (u + 0x7fffu + ((u >> 16) & 1u)) >> 16; }
__device__ __forceinline__ unsigned pk2(float lo, float hi) { return f2bf(lo) | (f2bf(hi) << 16); }
__device__ __forceinline__ float bf2f(bf16 v) { return __builtin_bit_cast(float, (unsigned)v << 16); }
__device__ __forceinline__ float bflo(unsigned u) { return __builtin_bit_cast(float, u << 16); }
__device__ __forceinline__ float bfhi(unsigned u) { return __builtin_bit_cast(float, u & 0xffff0000u); }
__device__ __forceinline__ float sigmoidf_(float x) { return 1.0f / (1.0f + __expf(-x)); }

#define XB_TMO      128
#define XB_XCNT(j)  (256  + 64 * (j))
#define XB_XSUB(j)  (1280 + 64 * (j))
#define XB_XGEN(j)  (2304 + 64 * (j))
#define XB_TOP      3328
#define XB_TOPGEN   3392
#define XCD_BAR_WORDS 3456
#define XB_SPIN_CAP (1u << 18)

__device__ __forceinline__ unsigned xb_ld(unsigned* p)              { return __hip_atomic_load(p, __ATOMIC_RELAXED, __HIP_MEMORY_SCOPE_AGENT); }
__device__ __forceinline__ unsigned xb_add(unsigned* p, unsigned v) { return __hip_atomic_fetch_add(p, v, __ATOMIC_RELAXED, __HIP_MEMORY_SCOPE_AGENT); }
__device__ __forceinline__ unsigned xb_xcc_id() { return (unsigned)__builtin_amdgcn_s_getreg((3 << 11) | 20) & 0xFu; }
#define XB_SPIN(cond, bar) do { unsigned _sp = 0; while (cond) { __builtin_amdgcn_s_sleep(1); \
    if ((++_sp & 255u) == 0u) { if (xb_ld(&(bar)[XB_TMO])) break; if (_sp > XB_SPIN_CAP) { atomicAdd(&(bar)[XB_TMO], 1u); break; } } } } while (0)

struct XcdBarrier {
    unsigned* bar; unsigned x;
    volatile LAS unsigned* st;
};

__device__ __forceinline__ XcdBarrier xcd_barrier_post(unsigned* bar, volatile LAS unsigned* st) {
    XcdBarrier b; b.bar = bar; b.x = xb_xcc_id(); b.st = st;
    if (threadIdx.x == 0) (void)xb_add(&bar[XB_XCNT(b.x)], 1u);
    return b;
}
__device__ __forceinline__ void xcd_barrier_complete(unsigned* bar, unsigned x, unsigned& nloc, unsigned& nx) {
    const unsigned G = gridDim.x * gridDim.y * gridDim.z;
    unsigned sum, cnt, mine, sp = 0u;
    for (;;) {
        sum = 0u; cnt = 0u; mine = 0u;
#pragma unroll
        for (unsigned j = 0; j < 16; ++j) { const unsigned c = xb_ld(&bar[XB_XCNT(j)]); sum += c; cnt += (c > 0u) ? 1u : 0u; mine = (j == x) ? c : mine; }
        if (sum == G) break;
        __builtin_amdgcn_s_sleep(1);
        if ((++sp & 255u) == 0u) { if (xb_ld(&bar[XB_TMO])) break; if (sp > XB_SPIN_CAP) { atomicAdd(&bar[XB_TMO], 1u); break; } }
    }
    nloc = mine > 0u ? mine : 1u; nx = cnt > 0u ? cnt : 1u;
}

__device__ __forceinline__ void xcd_barrier(const XcdBarrier& b) {
    asm volatile("s_waitcnt vmcnt(0)" ::: "memory");
    __syncthreads();
    if (threadIdx.x == 0) {
        unsigned* bar = b.bar;
        __builtin_amdgcn_s_waitcnt(0);
        unsigned nloc = b.st[0], nx = b.st[1];
        if (nloc == 0u) { xcd_barrier_complete(bar, b.x, nloc, nx); b.st[0] = nloc; b.st[1] = nx; }
        const unsigned old = xb_add(&bar[XB_XSUB(b.x)], 1u);
        const unsigned gen = old / nloc;
        if (old + 1u == (gen + 1u) * nloc) {
            __builtin_amdgcn_fence(__ATOMIC_RELEASE, "agent");
            asm volatile("s_waitcnt vmcnt(0)" ::: "memory");
            const unsigned og = xb_add(&bar[XB_TOP], 1u);
            const unsigned tg = og / nx;
            if (og + 1u == (tg + 1u) * nx) xb_add(&bar[XB_TOPGEN], 1u);
            else XB_SPIN(xb_ld(&bar[XB_TOPGEN]) == tg, bar);
            __builtin_amdgcn_fence(__ATOMIC_ACQUIRE, "agent");
            xb_add(&bar[XB_XGEN(b.x)], 1u);
            asm volatile("s_waitcnt vmcnt(0)" ::: "memory");
        } else {
            XB_SPIN(xb_ld(&bar[XB_XGEN(b.x)]) == gen, bar);
            __builtin_amdgcn_fence(__ATOMIC_ACQUIRE, "agent");
            asm volatile("s_waitcnt vmcnt(0)" ::: "memory");
        }
    }
    __syncthreads();
}


struct Frame {
    LAS unsigned char* lds;
    volatile LAS unsigned* MISC;
    gu32* ctl;
    int tid, lane, wave;
    int vcu, G;
};
__device__ __forceinline__ float wave_sum(float v) {
#pragma unroll
    for (int o = 1; o < 64; o <<= 1) v += __shfl_xor(v, o);
    return v;
}
__device__ __forceinline__ void p0_transpose_tile(const float* Wt, int N, bf16* WTt, int K, LAS float* scr, int lane) {
    float tv[32];
#pragma unroll
    for (int i = 0; i < 32; ++i) tv[i] = __builtin_nontemporal_load(&Wt[(size_t)(2 * i + (lane >> 5)) * N + (lane & 31)]);
#pragma unroll
    for (int i = 0; i < 32; ++i) scr[(2 * i + (lane >> 5)) * 33 + (lane & 31)] = tv[i];
    LDS_WAIT(); asm volatile("" ::: "memory");
    const int c = lane & 7;
#pragma unroll
    for (int j = 0; j < 4; ++j) { const int n = (lane >> 3) + 8 * j; const LAS float* s = scr + (8 * c) * 33 + n;
        v4u o; o.x = pk2(s[0 * 33], s[1 * 33]); o.y = pk2(s[2 * 33], s[3 * 33]); o.z = pk2(s[4 * 33], s[5 * 33]); o.w = pk2(s[6 * 33], s[7 * 33]);
        *(GAS v4u*)(WTt + (size_t)n * K + 8 * c) = o; }
    LDS_WAIT(); asm volatile("" ::: "memory");
}


#define HG_MFMA(a, b, c) __builtin_amdgcn_mfma_f32_16x16x32_bf16((a), (b), (c), 0, 0, 0)
namespace hg {
#ifndef HGP
#define HGP 0
#endif
constexpr int QT_OFF = 0, KT_OFF = 12288, KET_OFF = 22528, DEC_OFF = 34816, BUFSZ = 35328, SSQ_OFF = 2 * BUFSZ, RAW_OFF = SSQ_OFF + 2048, RAWSZ = 4 * 8704, OUT_OFF = RAW_OFF + 2 * RAWSZ, OUTSZ = 8704, PB_OFF = OUT_OFF + 2 * OUTSZ, LDS_NEED = PB_OFF + 2048;
constexpr int RF_OFF = 0, RQ_OFF = 8704, RV_OFF = 17408, RG_OFF = 26112;
constexpr int PT = 272, PC = 96, PCK = 80;
struct Raw { v4u f, q, v, g; };
template <bool FULL>
__device__ __forceinline__ void load_raw(Raw& R, const bf16* PROJ, size_t rowc, int h, int tid) {
    const size_t bb = rowc / T, tt = rowc - bb * T;
    const bf16* p = PROJ + PJ_XH + ((bb * 4 + h) * T + tt) * 128 + (size_t)tid * 8;
    if (FULL) { R.f = __builtin_nontemporal_load((const GAS v4u*)(p + PJ_XSZ)); R.v = __builtin_nontemporal_load((const GAS v4u*)(p + 2 * PJ_XSZ)); R.q = __builtin_nontemporal_load((const GAS v4u*)p); R.g = __builtin_nontemporal_load((const GAS v4u*)(p + 3 * PJ_XSZ)); }
    else { R.f = *(const GAS v4u*)(p + PJ_XSZ); R.v = *(const GAS v4u*)(p + 2 * PJ_XSZ); }
}
template <bool FULL>
__device__ __forceinline__ void store_raw(const Raw& R, LAS unsigned char* raw, int tid) {
    LAS unsigned char* d = raw + (tid >> 4) * PT + 16 * (tid & 15);
    *(LAS v4u*)(d + RF_OFF) = R.f; *(LAS v4u*)(d + RV_OFF) = R.v; if (FULL) { *(LAS v4u*)(d + RQ_OFF) = R.q; *(LAS v4u*)(d + RG_OFF) = R.g; }
}
__device__ __forceinline__ s16x4 vtr16(const LAS unsigned char* p) { return __builtin_bit_cast(s16x4, __builtin_amdgcn_ds_read_tr16_b64_v4i16((LAS v4i16_t*)p)); }
template <bool FULL>
__device__ __forceinline__ void prep(const LAS unsigned char* raw, LAS unsigned char* buf, float lb, int w, int r16, int q, float& Dacc) {
    const int key = 16 * w + r16;
    const LAS unsigned char* tp = raw + (8 * q + (r16 >> 2)) * PT + 32 * w + 8 * (r16 & 3);
    const v2u F0 = __builtin_bit_cast(v2u, vtr16(tp + RF_OFF)), F1 = __builtin_bit_cast(v2u, vtr16(tp + RF_OFF + 4 * PT));
    const float fx[8] = {bflo(F0.x), bfhi(F0.x), bflo(F0.y), bfhi(F0.y), bflo(F1.x), bfhi(F1.x), bflo(F1.y), bfhi(F1.y)};
    float fv[8], P[8];
#pragma unroll
    for (int i = 0; i < 8; ++i) fv[i] = lb + (1.0f - lb) * __builtin_amdgcn_rcpf(1.0f + __expf(-fx[i]));
    P[0] = fv[0];
#pragma unroll
    for (int i = 1; i < 8; ++i) P[i] = P[i - 1] * fv[i];
    const float gt = P[7];
    const float t0 = __shfl(gt, r16), t1 = __shfl(gt, r16 + 16), t2 = __shfl(gt, r16 + 32), t3 = __shfl(gt, r16 + 48);
    const float excl = (q > 0 ? t0 : 1.0f) * (q > 1 ? t1 : 1.0f) * (q > 2 ? t2 : 1.0f);
    const float Plast = (t0 * t1) * (t2 * t3);
    float ke[8], kd[8], qd[8];
    float qx[8] = {0.f, 0.f, 0.f, 0.f, 0.f, 0.f, 0.f, 0.f};
    if (FULL) { const v2u Q0 = __builtin_bit_cast(v2u, vtr16(tp + RQ_OFF)), Q1 = __builtin_bit_cast(v2u, vtr16(tp + RQ_OFF + 4 * PT));
        qx[0] = bflo(Q0.x); qx[1] = bfhi(Q0.x); qx[2] = bflo(Q0.y); qx[3] = bfhi(Q0.y); qx[4] = bflo(Q1.x); qx[5] = bfhi(Q1.x); qx[6] = bflo(Q1.y); qx[7] = bfhi(Q1.y); }
#pragma unroll
    for (int i = 0; i < 8; ++i) P[i] *= excl;
    float rP[8]; rP[7] = __builtin_amdgcn_rcpf(P[7]);
#pragma unroll
    for (int i = 7; i > 0; --i) rP[i - 1] = rP[i] * fv[i];
#pragma unroll
    for (int i = 0; i < 8; ++i) { kd[i] = (1.0f - fv[i]) * rP[i]; ke[i] = kd[i] * Plast;
        if (FULL) qd[i] = qx[i] * __builtin_amdgcn_rcpf(1.0f + __expf(-qx[i])) * P[i]; }
    *(LAS v4u*)(buf + KET_OFF + key * PC + 16 * q) = (v4u){cvtpk_s(ke[0], ke[1]), cvtpk_s(ke[2], ke[3]), cvtpk_s(ke[4], ke[5]), cvtpk_s(ke[6], ke[7])};
    if (FULL) { *(LAS v4u*)(buf + KT_OFF + key * PCK + 16 * q) = (v4u){cvtpk_s(kd[0], kd[1]), cvtpk_s(kd[2], kd[3]), cvtpk_s(kd[4], kd[5]), cvtpk_s(kd[6], kd[7])};
        *(LAS v4u*)(buf + QT_OFF + key * PC + 16 * q) = (v4u){cvtpk_s(qd[0], qd[1]), cvtpk_s(qd[2], qd[3]), cvtpk_s(qd[4], qd[5]), cvtpk_s(qd[6], qd[7])}; }
    if (q == 0) *(LAS float*)(buf + DEC_OFF + 4 * key) = Plast;
    Dacc *= Plast;
}
__device__ __forceinline__ void prep_state(const LAS unsigned char* raw, LAS unsigned char* buf, float lb, int w, int r16, int q, float& Dacc) {
    const int key = 16 * w + r16;
    const LAS unsigned char* tp = raw + (8 * q + (r16 >> 2)) * PT + 32 * w + 8 * (r16 & 3);
    const v2u F0 = __builtin_bit_cast(v2u, vtr16(tp)), F1 = __builtin_bit_cast(v2u, vtr16(tp + 4 * PT));
    const float fx[8] = {bflo(F0.x), bfhi(F0.x), bflo(F0.y), bfhi(F0.y), bflo(F1.x), bfhi(F1.x), bflo(F1.y), bfhi(F1.y)};
    float fv[8], Q[8];
#pragma unroll
    for (int i = 0; i < 8; ++i) fv[i] = lb + (1.0f - lb) * __builtin_amdgcn_rcpf(1.0f + __expf(-fx[i]));
    Q[7] = 1.0f;
#pragma unroll
    for (int i = 7; i > 0; --i) Q[i - 1] = Q[i] * fv[i];
    const float gt = Q[0] * fv[0];
    const float t0 = __shfl(gt, r16), t1 = __shfl(gt, r16 + 16), t2 = __shfl(gt, r16 + 32), t3 = __shfl(gt, r16 + 48);
    const float sfx = (q < 1 ? t1 : 1.0f) * (q < 2 ? t2 : 1.0f) * (q < 3 ? t3 : 1.0f);
    const float Plast = (t0 * t1) * (t2 * t3);
    float ke[8];
#pragma unroll
    for (int i = 0; i < 8; ++i) ke[i] = (1.0f - fv[i]) * (Q[i] * sfx);
    *(LAS v4u*)(buf + KET_OFF + key * PC + 16 * q) = (v4u){cvtpk_s(ke[0], ke[1]), cvtpk_s(ke[2], ke[3]), cvtpk_s(ke[4], ke[5]), cvtpk_s(ke[6], ke[7])};
    if (q == 0) *(LAS float*)(buf + DEC_OFF + 4 * key) = Plast;
    Dacc *= Plast;
}
#define HG_MFMA(a, b, c) __builtin_amdgcn_mfma_f32_16x16x32_bf16((a), (b), (c), 0, 0, 0)
__device__ __forceinline__ bf16x8 cat8(s16x4 lo, s16x4 hi) { return __builtin_shufflevector(lo, hi, 0, 1, 2, 3, 4, 5, 6, 7); }
__device__ __forceinline__ bf16x8 pack8(f32x4 lo, f32x4 hi) { v4u p = (v4u){cvtpk_s(lo[0], lo[1]), cvtpk_s(lo[2], lo[3]), cvtpk_s(hi[0], hi[1]), cvtpk_s(hi[2], hi[3])}; return __builtin_bit_cast(bf16x8, p); }
__device__ __forceinline__ float silu_g(float g) { return g * __builtin_amdgcn_rcpf(1.0f + __expf(-g)); }
__device__ __forceinline__ void finish(const LAS float* ssqp, f32x4 oa, f32x4 ob, v2u g0, v2u g1, f32x4 gn4, LAS unsigned char* outt, int w, int r16, int q) {
#pragma unroll
    for (int ct = 0; ct < 2; ++ct) { float tot = 0.f;
#pragma unroll
        for (int ww = 0; ww < 8; ++ww) tot += ssqp[ww * 32 + 16 * ct + r16];
        const float rstd = rsqrtf(tot * (1.f / 128.f) + NORM_EPS);
        const f32x4 o = ct ? ob : oa; const v2u gg = ct ? g1 : g0;
        const float y0 = o[0] * rstd * gn4[0] * silu_g(bflo(gg.x)), y1 = o[1] * rstd * gn4[1] * silu_g(bfhi(gg.x));
        const float y2 = o[2] * rstd * gn4[2] * silu_g(bflo(gg.y)), y3 = o[3] * rstd * gn4[3] * silu_g(bfhi(gg.y));
        *(LAS v2u*)(outt + (16 * ct + r16) * PT + 2 * (16 * w + 4 * q)) = (v2u){cvtpk_s(y0, y1), cvtpk_s(y2, y3)}; }
}
__device__ __forceinline__ void flush_out(const LAS unsigned char* outt, bf16* dst_row0, int tid) {
    *(GAS v4u*)(dst_row0 + (size_t)(tid >> 4) * D + 8 * (tid & 15)) = *(const LAS v4u*)(outt + (tid >> 4) * PT + 16 * (tid & 15));
}

__device__ __forceinline__ void atile(const LAS unsigned char* buf, LAS unsigned char* pb, int w, int l, int r16, int q) {
    if (w < 3) {
        const LAS unsigned char* ktr = buf + KT_OFF + (4 * q + (r16 >> 2)) * PCK + 8 * (r16 & 3) + (w == 2 ? 32 : 0);
        const LAS unsigned char* qtr = buf + QT_OFF + (4 * q + (r16 >> 2)) * PC + 8 * (r16 & 3) + (w >= 1 ? 32 : 0);
        f32x4 a = (f32x4){0.f, 0.f, 0.f, 0.f};
#pragma unroll
        for (int ks = 0; ks < 4; ++ks) a = HG_MFMA(cat8(vtr16(ktr + 32 * ks * PCK), vtr16(ktr + (32 * ks + 16) * PCK)), cat8(vtr16(qtr + 32 * ks * PC), vtr16(qtr + (32 * ks + 16) * PC)), a);
        if (w != 1) {
#pragma unroll
            for (int r = 0; r < 4; ++r) a[r] = ((4 * q + r) <= r16) ? a[r] : 0.f; }
        *(LAS v2u*)(pb + 32 * l + (w == 0 ? 0 : 8 + 8 * w)) = (v2u){cvtpk_s(a[0], a[1]), cvtpk_s(a[2], a[3])};
    }
}
#define HG_BAR() asm volatile("s_waitcnt lgkmcnt(0)\n\ts_barrier" ::: "memory")
#define HG_BODY(NN, RLOAD, RSTORE) do { const int n = (NN); \
        LAS unsigned char* buf = lds + (n & 1) * BUFSZ; \
        const LAS unsigned char* rawc = lds + RAW_OFF + (n & 1) * RAWSZ; \
        load_raw<FULL>(RLOAD, PROJ, row0 + 32 * (n + 3 < 32 ? n + 3 : 31), h, tid); \
        f32x4 o0 = (f32x4){0.f, 0.f, 0.f, 0.f}, o1 = o0; v2u g0 = (v2u){0u, 0u}, g1 = g0; \
        const LAS unsigned char* vtr = rawc + RV_OFF + (r16 >> 2) * PT + 32 * w + 8 * (r16 & 3); \
        if (FULL) { \
            g0 = *(const LAS v2u*)(rawc + RG_OFF + r16 * PT + 2 * (16 * w + 4 * q)); g1 = *(const LAS v2u*)(rawc + RG_OFF + (16 + r16) * PT + 2 * (16 * w + 4 * q)); \
            const LAS unsigned char* qt2 = buf + QT_OFF + (4 * q + (r16 >> 2)) * PC + 8 * (r16 & 3); \
            const v2u pa = *(const LAS v2u*)(lds + PB_OFF + 32 * l); \
            const bf16x8 pb0 = __builtin_bit_cast(bf16x8, ((v4u){pa.x, pa.y, 0u, 0u})), pb1 = *(const LAS bf16x8*)(lds + PB_OFF + 32 * l + 16); \
            const bf16x8 va = cat8(vtr16(vtr + (4 * q) * PT), vtr16(vtr + (16 + 4 * q) * PT)); \
            o0 = HG_MFMA(va, pb0, o0); o1 = HG_MFMA(va, pb1, o1); \
_Pragma("unroll") \
            for (int i = 0; i < 4; ++i) { \
                const bf16x8 sa = pack8(S[2 * i], S[2 * i + 1]); \
                const bf16x8 b0 = cat8(vtr16(qt2 + 32 * i * PC), vtr16(qt2 + (32 * i + 16) * PC)), b1 = cat8(vtr16(qt2 + 32 * i * PC + 32), vtr16(qt2 + (32 * i + 16) * PC + 32)); \
                o0 = HG_MFMA(sa, b0, o0); o1 = HG_MFMA(sa, b1, o1); } \
            float p0 = (o0[0] * o0[0] + o0[1] * o0[1]) + (o0[2] * o0[2] + o0[3] * o0[3]), p1 = (o1[0] * o1[0] + o1[1] * o1[1]) + (o1[2] * o1[2] + o1[3] * o1[3]); \
            p0 += __shfl_xor(p0, 16); p0 += __shfl_xor(p0, 32); p1 += __shfl_xor(p1, 16); p1 += __shfl_xor(p1, 32); \
            if (q == 0) { ssq[((n & 1) * 8 + w) * 32 + r16] = p0; ssq[((n & 1) * 8 + w) * 32 + 16 + r16] = p1; } \
        } \
        { \
            const bf16x8 vb = cat8(vtr16(vtr + (8 * q) * PT), vtr16(vtr + (8 * q + 4) * PT)); \
_Pragma("unroll") \
            for (int kt = 0; kt < 8; ++kt) { const f32x4 d4 = *(const LAS f32x4*)(buf + DEC_OFF + 4 * (16 * kt + 4 * q)); \
                const bf16x8 ka = *(const LAS bf16x8*)(buf + KET_OFF + (16 * kt + r16) * PC + 16 * q); \
                S[kt] = HG_MFMA(ka, vb, S[kt] * d4); } \
        } \
        HG_BAR(); \
        if (n + 1 < 32) prep<FULL>(lds + RAW_OFF + ((n + 1) & 1) * RAWSZ, lds + ((n + 1) & 1) * BUFSZ, lb, w, r16, q, Dacc); \
        if (FULL && n > 0) flush_out(lds + OUT_OFF + ((n - 1) & 1) * OUTSZ, orow + (size_t)(32 * (n - 1)) * D, tid); \
        HG_BAR(); \
        if (FULL) finish(ssq + (n & 1) * 256, o0, o1, g0, g1, gn4, lds + OUT_OFF + (n & 1) * OUTSZ, w, r16, q); \
        store_raw<FULL>(RSTORE, lds + RAW_OFF + (n & 1) * RAWSZ, tid); \
        if (FULL && n + 1 < 32) atile(lds + ((n + 1) & 1) * BUFSZ, lds + PB_OFF, w, l, r16, q); \
        HG_BAR(); \
    } while (0)
template <bool FULL, int NCH = 32>
__device__ __forceinline__ void unit(LAS unsigned char* lds, int tid, int un_, const bf16* PROJ, const float* lbv, float* Ubuf, float* Dbuf, const float* gnorm, bf16* MIXIN) {
    const int w = __builtin_amdgcn_readfirstlane(tid >> 6), l = tid & 63, r16 = l & 15, q = l >> 4;
    const int b = un_ >> 5, h = (un_ >> 3) & 3, seg = un_ & 7;
    const size_t row0 = (size_t)b * T + (size_t)seg * 1024;
    const float lb = lbv[h * 128 + 16 * w + r16];
    LAS float* ssq = (LAS float*)(lds + SSQ_OFF);
    f32x4 S[8];
#pragma unroll
    for (int kt = 0; kt < 8; ++kt) S[kt] = (f32x4){0.f, 0.f, 0.f, 0.f};
    Raw R, R1;
    load_raw<FULL>(R, PROJ, row0, h, tid);
    if (FULL) {
        f32x4 un[8], dn[8];
        if (seg > 0) { const float* Uj = Ubuf + ((size_t)(un_ - seg) * 8 + w) * 2048; const float* Dj = Dbuf + (size_t)(un_ - seg) * 128;
#pragma unroll
            for (int kt = 0; kt < 8; ++kt) { dn[kt] = *(const f32x4*)(Dj + 16 * kt + 4 * q); un[kt] = *(const f32x4*)(Uj + (kt * 64 + l) * 4); } }
        for (int j = 0; j < seg; ++j) {
            f32x4 uc[8], dc[8];
#pragma unroll
            for (int kt = 0; kt < 8; ++kt) { uc[kt] = un[kt]; dc[kt] = dn[kt]; }
            if (j + 1 < seg) { const float* Uj = Ubuf + ((size_t)(un_ - seg + j + 1) * 8 + w) * 2048; const float* Dj = Dbuf + (size_t)(un_ - seg + j + 1) * 128;
#pragma unroll
                for (int kt = 0; kt < 8; ++kt) { dn[kt] = *(const f32x4*)(Dj + 16 * kt + 4 * q); un[kt] = *(const f32x4*)(Uj + (kt * 64 + l) * 4); } }
#pragma unroll
            for (int kt = 0; kt < 8; ++kt) S[kt] = S[kt] * dc[kt] + uc[kt];
        }
    }
    float Dacc = 1.0f;
    f32x4 gn4 = (f32x4){0.f, 0.f, 0.f, 0.f};
    if (FULL) gn4 = *(const f32x4*)(gnorm + h * 128 + 16 * w + 4 * q);
    store_raw<FULL>(R, lds + RAW_OFF, tid);
    load_raw<FULL>(R, PROJ, row0 + 32, h, tid);
    __syncthreads();
    prep<FULL>(lds + RAW_OFF, lds, lb, w, r16, q, Dacc);
    store_raw<FULL>(R, lds + RAW_OFF + RAWSZ, tid);
    load_raw<FULL>(R, PROJ, row0 + 64, h, tid);
    __syncthreads();
    if (FULL) { atile(lds, lds + PB_OFF, w, l, r16, q); __syncthreads(); }
    bf16* const orow = MIXIN + row0 * D + 512 + h * 128;
    for (int n2 = 0; n2 < NCH; n2 += 2) { HG_BODY(n2, R1, R); HG_BODY(n2 + 1, R, R1); }
    if (FULL) { __syncthreads(); flush_out(lds + OUT_OFF + OUTSZ, orow + (size_t)(32 * 31) * D, tid); }
    if (!FULL) {
        float* Uo = Ubuf + ((size_t)un_ * 8 + w) * 2048;
#pragma unroll
        for (int kt = 0; kt < 8; ++kt) *(f32x4*)(Uo + (kt * 64 + l) * 4) = S[kt];
        if (q == 0) Dbuf[(size_t)un_ * 128 + 16 * w + r16] = Dacc;
    }
    __syncthreads();
}
constexpr int SP_RAWC = 2 * 8704, SP_RAWP = 2 * SP_RAWC, SP_IMG_OFF = 3 * SP_RAWP, SP_IMG = 12800, SP_NEED = SP_IMG_OFF + 4 * SP_IMG;
struct Raw2 { v4u f0, v0, f1, v1; };
__device__ __forceinline__ void sp_load(Raw2& R, const bf16* PROJ, size_t rowc, int h, int tid) {
    const size_t bb = rowc / T, tt = rowc - bb * T;
    const bf16* p = PROJ + PJ_XH + ((bb * 4 + h) * T + tt) * 128 + (size_t)tid * 8;
    R.f0 = *(const GAS v4u*)(p + PJ_XSZ); R.v0 = *(const GAS v4u*)(p + 2 * PJ_XSZ); R.f1 = *(const GAS v4u*)(p + PJ_XSZ + 32 * 128); R.v1 = *(const GAS v4u*)(p + 2 * PJ_XSZ + 32 * 128);
}
__device__ __forceinline__ void sp_store(const Raw2& R, LAS unsigned char* raw, int tid) {
    LAS unsigned char* d = raw + (tid >> 4) * PT + 16 * (tid & 15);
    *(LAS v4u*)d = R.f0; *(LAS v4u*)(d + 8704) = R.v0; *(LAS v4u*)(d + SP_RAWC) = R.f1; *(LAS v4u*)(d + SP_RAWC + 8704) = R.v1;
}
#define SP_UPD(IMGP, RAWP) do { const LAS unsigned char* im_ = (IMGP); const LAS unsigned char* vt_ = (RAWP) + 8704 + (r16 >> 2) * PT + 32 * w + 8 * (r16 & 3); \
        const bf16x8 vb = cat8(vtr16(vt_ + (8 * q) * PT), vtr16(vt_ + (8 * q + 4) * PT)); \
_Pragma("unroll") \
        for (int kt = 0; kt < 8; ++kt) { const f32x4 d4 = *(const LAS f32x4*)(im_ + 12288 + 4 * (16 * kt + 4 * q)); \
            const bf16x8 ka = *(const LAS bf16x8*)(im_ + (16 * kt + r16) * PC + 16 * q); \
            S[kt] = HG_MFMA(ka, vb, S[kt] * d4); } } while (0)
#define SP_PBUF(k) (lds + SP_IMG_OFF + (k) * SP_IMG - KET_OFF)
#define SP_STEP(MM, RLOAD, RSTORE) do { const int m = (MM), pp = m & 1; \
        sp_load(RLOAD, PROJ, row0 + 64 * (m + 3 < 16 ? m + 3 : 15), h, tid); \
        SP_UPD(lds + SP_IMG_OFF + (2 * pp) * SP_IMG, lds + o0); \
        SP_UPD(lds + SP_IMG_OFF + (2 * pp + 1) * SP_IMG, lds + o0 + SP_RAWC); \
        if (m + 1 < 16) { prep_state(lds + o1, SP_PBUF(2 * (pp ^ 1)), lb, w, r16, q, Dacc); prep_state(lds + o1 + SP_RAWC, SP_PBUF(2 * (pp ^ 1) + 1), lb, w, r16, q, Dacc); } \
        if (m + 2 < 16) sp_store(RSTORE, lds + o2, tid); \
        HG_BAR(); \
        { const int t_ = o0; o0 = o1; o1 = o2; o2 = t_; } \
    } while (0)
__device__ __forceinline__ void unit_state(LAS unsigned char* lds, int tid, int un_, const bf16* PROJ, const float* lbv, float* Ubuf, float* Dbuf) {
    const int w = __builtin_amdgcn_readfirstlane(tid >> 6), l = tid & 63, r16 = l & 15, q = l >> 4;
    const int b = un_ >> 5, h = (un_ >> 3) & 3, seg = un_ & 7;
    const size_t row0 = (size_t)b * T + (size_t)seg * 1024;
    const float lb = lbv[h * 128 + 16 * w + r16];
    f32x4 S[8];
#pragma unroll
    for (int kt = 0; kt < 8; ++kt) S[kt] = (f32x4){0.f, 0.f, 0.f, 0.f};
    float Dacc = 1.0f;
    Raw2 RA, RB;
    sp_load(RA, PROJ, row0, h, tid);
    sp_store(RA, lds, tid);
    sp_load(RA, PROJ, row0 + 64, h, tid);
    __syncthreads();
    prep_state(lds, SP_PBUF(0), lb, w, r16, q, Dacc); prep_state(lds + SP_RAWC, SP_PBUF(1), lb, w, r16, q, Dacc);
    sp_store(RA, lds + SP_RAWP, tid);
    sp_load(RA, PROJ, row0 + 128, h, tid);
    __syncthreads();
    int o0 = 0, o1 = SP_RAWP, o2 = 2 * SP_RAWP;
    for (int m2 = 0; m2 < 16; m2 += 2) { SP_STEP(m2, RB, RA); SP_STEP(m2 + 1, RA, RB); }
    float* Uo = Ubuf + ((size_t)un_ * 8 + w) * 2048;
#pragma unroll
    for (int kt = 0; kt < 8; ++kt) *(f32x4*)(Uo + (kt * 64 + l) * 4) = S[kt];
    if (q == 0) Dbuf[(size_t)un_ * 128 + 16 * w + r16] = Dacc;
    __syncthreads();
}
}

struct Args { const float* in[21]; float* out; unsigned char* ws; int ph_lo, ph_hi; };

__global__ void __launch_bounds__(NWAVES * 64, 2) fwd(Args args) {
    extern __shared__ __attribute__((aligned(16))) unsigned char lds[];
    Frame F;
    F.lds = (LAS unsigned char*)lds;
    F.MISC = (volatile LAS unsigned*)(F.lds + MISC_OFF);
    F.tid = threadIdx.x; F.lane = F.tid & 63; F.wave = __builtin_amdgcn_readfirstlane(F.tid >> 6);
    F.G = gridDim.x; { const int bx = blockIdx.x; F.vcu = (F.G % 8 == 0) ? (bx % 8) * (F.G / 8) + bx / 8 : bx; }
    unsigned char* ws = args.ws;
    F.ctl = (gu32*)(ws + WS_CTL);
    for (int u = F.tid; u < (LDS_BYTES - LDSCTL_OFF) / 4; u += NWAVES * 64) ((LAS unsigned*)(F.lds + LDSCTL_OFF))[u] = 0u;
    __syncthreads();
    XcdBarrier bar; bar.bar = (unsigned*)(F.ctl + CW_BAR); bar.x = 0; bar.st = nullptr;
    if (N_LAUNCHES == 1) bar = xcd_barrier_post((unsigned*)(F.ctl + CW_BAR), F.MISC + 8);
#define GRID_BAR() do { if (N_LAUNCHES == 1) xcd_barrier(bar); } while (0)
    const int lo = args.ph_lo, hi = args.ph_hi;
#define IN(k) (lo <= (k) && (k) < hi)
#define BOTH(k) (IN(k) && IN((k) + 1))
#ifndef REPMASK
#define REPMASK 0
#endif
#define REPS(k) ((((REPMASK) >> (k)) & 1) + 1)

    const float* x = args.in[0];
    float* mod = (float*)(ws + WS_MOD);
    float* lbv = (float*)(ws + WS_LB);
    bf16* Win_t = (bf16*)(ws + WS_WIN); bf16* Wout_t = (bf16*)(ws + WS_WOUT); bf16* Wgu_t = (bf16*)(ws + WS_WGU); bf16* Wd_t = (bf16*)(ws + WS_WD);
    bf16* WrT = (bf16*)(ws + WS_WRT);
 float* Useg = (float*)(ws + WS_U); float* Dseg = (float*)(ws + WS_DSEG);
    v2i* list2 = (v2i*)(ws + WS_LIST); v2i* tokpos = (v2i*)(ws + WS_TOKPOS); bf16* ACT = (bf16*)(ws + WS_ACT); unsigned char* Y8 = (unsigned char*)(ws + WS_Y); gu32* ecnt = F.ctl + CW_CNT;
    bf16* Hb = (bf16*)(ws + WS_H); bf16* PROJ = (bf16*)(ws + WS_PROJ); bf16* MIXIN = (bf16*)(ws + WS_MIXIN); bf16* X1 = (bf16*)(ws + WS_X1);
    bf16* MIX = Hb; bf16* H2 = MIXIN;
    const int gw = F.vcu * NWAVES + F.wave, NGW = F.G * NWAVES;

    if (IN(0)) _Pragma("unroll") for (int rep_ = 0; rep_ < REPS(0); ++rep_) {
        F.lane = lane_id_v(); F.tid = F.wave * 64 + F.lane;
        LAS float* scr = (LAS float*)(F.lds + RING_OFF + F.wave * 16384);
        constexpr int I_IN = (D / 64) * (NPROJ / 32), I_OUT = (D / 64) * (D / 32), I_G = NEXP * (D / 64) * (FF / 32), I_D = NEXP * (FF / 64) * (D / 32);
        for (int it = gw; it < I_IN + I_OUT + 2 * I_G + I_D; it += NGW) {
            int r = it;
            if (r < I_IN) { const int nblk = NPROJ / 32, k0 = 64 * (r / nblk), n0 = 32 * (r % nblk);
                p0_transpose_tile(args.in[8] + (size_t)k0 * NPROJ + n0, NPROJ, Win_t + (size_t)n0 * D + k0, D, scr, F.lane); continue; } r -= I_IN;
            if (r < I_OUT) { const int nblk = D / 32, k0 = 64 * (r / nblk), n0 = 32 * (r % nblk);
                p0_transpose_tile(args.in[13] + (size_t)k0 * D + n0, D, Wout_t + (size_t)n0 * D + k0, D, scr, F.lane); continue; } r -= I_OUT;
            if (r < 2 * I_G) { const int up = r >= I_G; if (up) r -= I_G;
                const int e = r / 128, q = r % 128, k0 = 64 * (q / 8), n0 = 32 * (q % 8);
                const int drow = (n0 >> 7) * 256 + (up ? 128 : 0) + (n0 & 127);
                p0_transpose_tile(args.in[up ? 19 : 18] + (size_t)e * D * FF + (size_t)k0 * FF + n0, FF, Wgu_t + ((size_t)e * 512 + drow) * D + k0, D, scr, F.lane); continue; } r -= 2 * I_G;
            { const int e = r / 128, q = r % 128, k0 = 64 * (q / 32), n0 = 32 * (q % 32);
              p0_transpose_tile(args.in[20] + (size_t)e * FF * D + (size_t)k0 * D + n0, D, Wd_t + ((size_t)e * D + n0) * FF + k0, FF, scr, F.lane); }
        }
        __syncthreads();
        F.lane = lane_id_v(); F.tid = F.wave * 64 + F.lane;
        LAS float* cs = (LAS float*)(F.lds);
        LAS float* red = (LAS float*)(F.lds + 32768);
        _Pragma("unroll") for (int rm_ = 0; rm_ < REPS(12); ++rm_)
        for (int item = blockIdx.x; item < 192; item += F.G) {
            for (int i = F.tid; i < 8 * 1024; i += 512) { const float cv = args.in[1][i]; cs[i] = cv * sigmoidf_(cv); }
            __syncthreads();
            float a[8];
#pragma unroll
            for (int b = 0; b < 8; ++b) a[b] = 0.f;
            const int col = F.lane & 31, kb = 128 * F.wave + 64 * (F.lane >> 5);
            const float* wp = args.in[6] + (size_t)kb * 6144 + item * 32 + col;
#pragma unroll 1
            for (int k0 = 0; k0 < 64; k0 += 16) { float wv[16];
#pragma unroll
                for (int k = 0; k < 16; ++k) wv[k] = __builtin_nontemporal_load(&wp[(size_t)(k0 + k) * 6144]);
#pragma unroll
                for (int b = 0; b < 8; ++b)
#pragma unroll
                    for (int k4 = 0; k4 < 16; k4 += 4) { const f32x4 c4 = *(const LAS f32x4*)(cs + b * 1024 + kb + k0 + k4);
                        a[b] += c4[0] * wv[k4] + c4[1] * wv[k4 + 1] + c4[2] * wv[k4 + 2] + c4[3] * wv[k4 + 3]; } }
#pragma unroll
            for (int b = 0; b < 8; ++b) { a[b] += __shfl_xor(a[b], 32); if (F.lane < 32) red[(F.wave * 8 + b) * 32 + col] = a[b]; }
            __syncthreads();
            if (F.tid < 256) { const int b = F.tid >> 5, c = F.tid & 31; float s_ = args.in[7][item * 32 + c];
#pragma unroll
              for (int w = 0; w < 8; ++w) s_ += red[(w * 8 + b) * 32 + c];
              mod[b * 6144 + item * 32 + c] = s_; }
            __syncthreads();
        }
        for (int i = blockIdx.x * 512 + F.tid; i < 48 * 1024; i += F.G * 512) { const int n = i >> 10, k = i & 1023;
            const float wv = n < 4 ? args.in[14][k * 4 + n] : (n < 36 ? args.in[16][k * 32 + (n - 4)] : 0.f);
            const unsigned hi = f2bf(wv); const float lo = wv - bflo(hi);
            WrT[i] = (bf16)hi; WrT[48 * 1024 + i] = (bf16)f2bf(lo); }
        if (blockIdx.x == (unsigned)(F.G - 1)) { const int i = F.tid; const float a0 = args.in[11][i], a1 = args.in[11][512 + i]; lbv[i] = 1.0f / (1.0f + __expf(a1 - a0)); }
        if (BOTH(0)) GRID_BAR();
    }

    if (IN(1)) _Pragma("unroll") for (int rep_ = 0; rep_ < REPS(1); ++rep_) {
        F.lane = lane_id_v(); F.tid = F.wave * 64 + F.lane;
        const float* g1 = args.in[2];
        f32x4 vn[4];
        if (gw < M) { const GAS f32x4* xr = (const GAS f32x4*)(x + (size_t)gw * D) + F.lane;
#pragma unroll
            for (int j = 0; j < 4; ++j) vn[j] = __builtin_nontemporal_load(&xr[64 * j]); }
        for (int m = gw; m < M; m += NGW) {
            const int b = m / T;
            f32x4 v[4]; float s = 0.f;
#pragma unroll
            for (int j = 0; j < 4; ++j) { v[j] = vn[j]; s += (v[j].x * v[j].x + v[j].y * v[j].y) + (v[j].z * v[j].z + v[j].w * v[j].w); }
            if (m + NGW < M) { const GAS f32x4* xr = (const GAS f32x4*)(x + (size_t)(m + NGW) * D) + F.lane;
#pragma unroll
                for (int j = 0; j < 4; ++j) vn[j] = __builtin_nontemporal_load(&xr[64 * j]); }
            const float rstd = rsqrtf(wave_sum(s) * (1.f / D) + NORM_EPS);
            GAS v2u* o8 = (GAS v2u*)(Hb + (size_t)m * D) + F.lane;
#pragma unroll
            for (int j = 0; j < 4; ++j) { const int k = 4 * F.lane + 256 * j;
                const f32x4 g = *(const f32x4*)(g1 + k), sh = *(const f32x4*)(mod + b * 6144 + k), sc = *(const f32x4*)(mod + b * 6144 + 1024 + k);
                const f32x4 h = v[j] * rstd * g * (sc + 1.0f) + sh;
                v2u o; o.x = pk2(h.x, h.y); o.y = pk2(h.z, h.w); o8[64 * j] = o; }
        }
        if (BOTH(1)) GRID_BAR();
    }

    if (IN(2)) _Pragma("unroll") for (int rep_ = 0; rep_ < REPS(2); ++rep_) {
        F.lane = lane_id_v(); F.tid = F.wave * 64 + F.lane;
        pg8::PlainProb P{(const char*)Hb, (const char*)Win_t, D}; pg8::StaticOrder S; S.init(M, NPROJ, F.G, (int)blockIdx.x);
        pg8::EpiProj E{PROJ, T, PJ_KA, PJ_VA, PJ_XH, PJ_XSZ, F.lds + CS_OFF + F.wave * 2048};
        pg8::gemm_phase2<pg8::PlainProb, pg8::EpiProj, pg8::StaticOrder, true>(F.lds + RING_OFF, P, S, E, F.wave);
        if (BOTH(2)) GRID_BAR();
    }

    if (IN(3)) _Pragma("unroll") for (int rep_ = 0; rep_ < REPS(3); ++rep_) {
        F.lane = lane_id_v(); F.tid = F.wave * 64 + F.lane;
        static_assert(hg::LDS_NEED <= P3_LDS_END && hg::SP_NEED <= P3_LDS_END, "hgrn LDS");
        _Pragma("unroll") for (int rs_ = 0; rs_ < REPS(10); ++rs_)
        for (int un = blockIdx.x; un < 256; un += F.G) hg::unit_state(F.lds, F.tid, un, PROJ, lbv, Useg, Dseg);
        {
            LAS unsigned char* Ks = F.lds;
            LAS unsigned char* Vs = F.lds + 73728;
            LAS float* ssq = (LAS float*)(F.lds + 147456);
            static_assert(147456 + 4096 <= P3_LDS_END, "attention LDS");
            const float* sinks = args.in[9]; const float* anorm = args.in[10];
            const int h = F.wave, g = h >> 2, ql = F.lane & 31, hf = F.lane >> 5;
            const float LOG2E = 1.4426950408889634f;
            const float c1 = 0.125f * LOG2E, slope2 = exp2f(-(float)(h + 1)) * LOG2E, sink2 = sinks[h] * LOG2E;
            for (int item2 = blockIdx.x; item2 < REPS(11) * (M / 128); item2 += F.G) { const int item = item2 & (M / 128 - 1);
                const int b = item >> 6, nb = item & 63, t0 = nb * 128; const size_t row0 = (size_t)b * T + t0;
                __syncthreads();
                {
                    const unsigned kto = (unsigned)F.tid * 16u;
                    LAS unsigned char* kl = Ks + (F.tid >> 3) * 144 + 16 * (F.tid & 7); LAS unsigned char* vl = Vs + (F.tid >> 3) * 144 + 16 * (F.tid & 7);
#pragma unroll
                    for (int i = 0; i < 8; ++i) { const int gg = i >> 2, k64 = 64 * (i & 3);
                        const char* kb = (const char*)(PROJ + PJ_KA) + ((size_t)(b * 2 + gg) * T + t0 - 128 + k64) * 128;
                        const char* vb = (const char*)(PROJ + PJ_VA) + ((size_t)(b * 2 + gg) * T + t0 - 128 + k64) * 128;
                        v4u kv = (v4u){0u, 0u, 0u, 0u}, vv = kv;
                        if (nb > 0 || (i & 3) >= 2) { kv = *(const GAS v4u*)(kb + kto); vv = *(const GAS v4u*)(vb + kto); }
                        *(LAS v4u*)(kl + (gg * 256 + k64) * 144) = kv; *(LAS v4u*)(vl + (gg * 256 + k64) * 144) = vv; }
                }
                __syncthreads();
                bf16x8 qn[4];
                { const bf16* qp = PROJ + PJ_QA + ((size_t)(b * 8 + h) * T + t0 + ql) * 64 + 8 * hf;
#pragma unroll
                  for (int s4 = 0; s4 < 4; ++s4) qn[s4] = __builtin_nontemporal_load((const GAS bf16x8*)(qp + 16 * s4)); }
                for (int qt = 0; qt < 4; ++qt) {
                    bf16x8 qf[4];
#pragma unroll
                    for (int s4 = 0; s4 < 4; ++s4) qf[s4] = qn[s4];
                    if (qt < 3) { const bf16* qp = PROJ + PJ_QA + ((size_t)(b * 8 + h) * T + t0 + 32 * (qt + 1) + ql) * 64 + 8 * hf;
#pragma unroll
                      for (int s4 = 0; s4 < 4; ++s4) qn[s4] = __builtin_nontemporal_load((const GAS bf16x8*)(qp + 16 * s4)); }
                    f32x16 st[5];
#pragma unroll
                    for (int k5 = 0; k5 < 5; ++k5) { f32x16 a;
#pragma unroll
                        for (int r = 0; r < 16; ++r) a[r] = 0.f;
                        const LAS unsigned char* kp = Ks + (g * 256 + (qt + k5) * 32 + ql) * 144 + 16 * hf;
#pragma unroll
                        for (int s4 = 0; s4 < 4; ++s4) { const bf16x8 ka = *(const LAS bf16x8*)(kp + 32 * s4); a = __builtin_amdgcn_mfma_f32_32x32x16_bf16(ka, qf[s4], a, 0, 0, 0); }
                        st[k5] = a; }
                    float mx = sink2;
                    const float lb0 = -slope2 * (float)(ql + 128 - 4 * hf);
#pragma unroll
                    for (int k5 = 0; k5 < 5; ++k5) { const bool tile_ok = (nb > 0) || (qt + k5 >= 4); const float lbk = lb0 + slope2 * (float)(32 * k5);
#pragma unroll
                        for (int r = 0; r < 16; ++r) { const int c0 = (r & 3) + 8 * (r >> 2);
                            float v = st[k5][r] * c1 + (lbk + slope2 * (float)c0);
                            bool ok = tile_ok;
                            if (k5 == 0) ok = ok && (c0 + 4 * hf > ql);
                            if (k5 == 4) ok = ok && (c0 + 4 * hf <= ql);
                            v = ok ? v : -1.0e30f; st[k5][r] = v; mx = fmaxf(mx, v); } }
                    mx = fmaxf(mx, __shfl_xor(mx, 32));
                    float sum = 0.f;
#pragma unroll
                    for (int k5 = 0; k5 < 5; ++k5)
#pragma unroll
                        for (int r = 0; r < 16; ++r) { const float p = __builtin_amdgcn_exp2f(st[k5][r] - mx);   st[k5][r] = p; sum += p; }
                    sum += __shfl_xor(sum, 32); sum += __builtin_amdgcn_exp2f(sink2 - mx);
                    const float inv = 1.0f / sum;
                    f32x16 o0, o1;
#pragma unroll
                    for (int r = 0; r < 16; ++r) { o0[r] = 0.f; o1[r] = 0.f; }
#pragma unroll
                    for (int k5 = 0; k5 < 5; ++k5)
#pragma unroll
                        for (int s2 = 0; s2 < 2; ++s2) {
                            v4u pp; pp.x = cvtpk_s(st[k5][8 * s2 + 0], st[k5][8 * s2 + 1]); pp.y = cvtpk_s(st[k5][8 * s2 + 2], st[k5][8 * s2 + 3]);
                            pp.z = cvtpk_s(st[k5][8 * s2 + 4], st[k5][8 * s2 + 5]); pp.w = cvtpk_s(st[k5][8 * s2 + 6], st[k5][8 * s2 + 7]);
                            const bf16x8 pb = __builtin_bit_cast(bf16x8, pp);
                            const int kb = (qt + k5) * 32 + 16 * s2 + 4 * hf; const int i16 = F.lane & 15, dsel = (F.lane >> 4) & 1;
                            const LAS unsigned char* vp = Vs + (g * 256 + kb + (i16 >> 2)) * 144 + (16 * dsel + 4 * (i16 & 3)) * 2;
                            { const s16x4 lo = vtr16(vp), hi = vtr16(vp + 8 * 144);
                              const bf16x8 va = __builtin_shufflevector(lo, hi, 0, 1, 2, 3, 4, 5, 6, 7); o0 = __builtin_amdgcn_mfma_f32_32x32x16_bf16(va, pb, o0, 0, 0, 0); }
                            { const s16x4 lo = vtr16(vp + 64), hi = vtr16(vp + 64 + 8 * 144);
                              const bf16x8 va = __builtin_shufflevector(lo, hi, 0, 1, 2, 3, 4, 5, 6, 7); o1 = __builtin_amdgcn_mfma_f32_32x32x16_bf16(va, pb, o1, 0, 0, 0); }
                        }
                    float sq = 0.f;
                    bf16* op = MIXIN + (row0 + 32 * qt + ql) * D + h * 64 + 4 * hf;
#pragma unroll
                    for (int rg = 0; rg < 4; ++rg) {
                        const float a0 = o0[4 * rg] * inv, a1 = o0[4 * rg + 1] * inv, a2 = o0[4 * rg + 2] * inv, a3 = o0[4 * rg + 3] * inv;
                        const float b0 = o1[4 * rg] * inv, b1 = o1[4 * rg + 1] * inv, b2 = o1[4 * rg + 2] * inv, b3 = o1[4 * rg + 3] * inv;
                        sq += (a0 * a0 + a1 * a1) + (a2 * a2 + a3 * a3) + (b0 * b0 + b1 * b1) + (b2 * b2 + b3 * b3);
                        *(GAS v2u*)(op + 8 * rg) = (v2u){cvtpk_s(a0, a1), cvtpk_s(a2, a3)};
                        *(GAS v2u*)(op + 32 + 8 * rg) = (v2u){cvtpk_s(b0, b1), cvtpk_s(b2, b3)}; }
                    sq += __shfl_xor(sq, 32);
                    if (hf == 0) ssq[h * 128 + 32 * qt + ql] = sq;
                }
                __syncthreads();
                { const f32x4 n0 = *(const f32x4*)(anorm + 8 * F.lane), n1 = *(const f32x4*)(anorm + 8 * F.lane + 4);
#pragma unroll
                  for (int i0 = 0; i0 < 16; i0 += 8) {
                    v4u uu[8];
#pragma unroll
                    for (int i = 0; i < 8; ++i) uu[i] = *(const GAS v4u*)(MIXIN + (row0 + 16 * F.wave + i0 + i) * D + 8 * F.lane);
#pragma unroll
                    for (int i = 0; i < 8; ++i) { const int tt = 16 * F.wave + i0 + i;
                        float ss = 0.f;
#pragma unroll
                        for (int hh = 0; hh < 8; ++hh) ss += ssq[hh * 128 + tt];
                        const float rstd = rsqrtf(ss * (1.f / 512.f) + NORM_EPS);
                        const v4u u = uu[i];
                        v4u o; o.x = cvtpk_s(bflo(u.x) * rstd * n0.x, bfhi(u.x) * rstd * n0.y); o.y = cvtpk_s(bflo(u.y) * rstd * n0.z, bfhi(u.y) * rstd * n0.w);
                        o.z = cvtpk_s(bflo(u.z) * rstd * n1.x, bfhi(u.z) * rstd * n1.y); o.w = cvtpk_s(bflo(u.w) * rstd * n1.z, bfhi(u.w) * rstd * n1.w);
                        *(GAS v4u*)(MIXIN + (row0 + tt) * D + 8 * F.lane) = o; } } }
            }
        }
        if (BOTH(3)) GRID_BAR();
    }

    if (IN(4)) _Pragma("unroll") for (int rep_ = 0; rep_ < REPS(4); ++rep_) {
        F.lane = lane_id_v(); F.tid = F.wave * 64 + F.lane;
        for (int un = blockIdx.x; un < 256; un += F.G) hg::unit<true>(F.lds, F.tid, un, PROJ, lbv, Useg, Dseg, args.in[12], MIXIN);
#if defined(P4DUP) && P4DUP
        for (int un = blockIdx.x; un < 256; un += F.G) hg::unit<true, P4DUP>(F.lds, F.tid, un, PROJ, lbv, Useg, Dseg, args.in[12], Hb);
#endif
        if (BOTH(4)) GRID_BAR();
    }

    if (IN(5)) _Pragma("unroll") for (int rep_ = 0; rep_ < REPS(5); ++rep_) {
        F.lane = lane_id_v(); F.tid = F.wave * 64 + F.lane;
        pg8::PlainProb P{(const char*)MIXIN, (const char*)Wout_t, D}; pg8::StaticOrder S; S.init(M, D, F.G, (int)blockIdx.x);
        pg8::EpiBf16W E{MIX, D, F.lds + CS_OFF + F.wave * 2048};
        pg8::gemm_phase2<pg8::PlainProb, pg8::EpiBf16W, pg8::StaticOrder, true, false>(F.lds + RING_OFF, P, S, E, F.wave);
        if (BOTH(5)) GRID_BAR();
    }

    if (IN(6)) {
        F.lane = lane_id_v(); F.tid = F.wave * 64 + F.lane;
        const float* g1p = args.in[3]; const float* g2 = args.in[4]; const float* brg = args.in[15]; const float* bre = args.in[17];
        constexpr int APITCH = 2064;
        LAS unsigned char* Ahi = F.lds; LAS unsigned char* Alo = F.lds + 16 * APITCH;
        LAS float* part = (LAS float*)(F.lds + 2 * 16 * APITCH);
        LAS float* red = part + 8 * 16 * 48;
        const int r16 = F.lane & 15, q4 = F.lane >> 4;
        int my_m = -1, my_e1 = 0, my_e2 = 0, my_w1 = 0, my_w2 = 0, nstep = 0;
        const int ngrp = M / 16;
        bf16x8 rbh[4][3];
#pragma unroll
        for (int ks = 0; ks < 4; ++ks)
#pragma unroll
            for (int nt = 0; nt < 3; ++nt) { const bf16* wp = WrT + (size_t)(16 * nt + r16) * 1024 + 128 * F.wave + 32 * ks + 8 * q4;
                rbh[ks][nt] = *(const GAS bf16x8*)wp; }
        v2u mixn[2][4]; f32x4 xnx[2][4];
#define P6_FETCH(gg) do { _Pragma("unroll") for (int rr_ = 0; rr_ < 2; ++rr_) { const int m_ = (gg) * 16 + 2 * F.wave + rr_; \
            const GAS v2u* mr_ = (const GAS v2u*)(MIX + (size_t)m_ * D) + F.lane; const GAS f32x4* xr_ = (const GAS f32x4*)(x + (size_t)m_ * D) + F.lane; \
            _Pragma("unroll") for (int j = 0; j < 4; ++j) { mixn[rr_][j] = __builtin_nontemporal_load(&mr_[64 * j]); xnx[rr_][j] = __builtin_nontemporal_load(&xr_[64 * j]); } } } while (0)
        if ((int)blockIdx.x < ngrp) P6_FETCH((int)blockIdx.x);
        for (int grp = blockIdx.x; grp < ngrp; grp += F.G) {
            const int m0 = grp * 16; const int b = m0 / T; const float* mb = mod + b * 6144;
            {
                f32x4 v[2][4]; float s1[2] = {0.f, 0.f}, s2[2] = {0.f, 0.f};
#pragma unroll
                for (int rr = 0; rr < 2; ++rr)
#pragma unroll
                    for (int j = 0; j < 4; ++j) { const v2u u = mixn[rr][j]; v[rr][j] = (f32x4){bflo(u.x), bfhi(u.x), bflo(u.y), bfhi(u.y)};
                        s1[rr] += (v[rr][j].x * v[rr][j].x + v[rr][j].y * v[rr][j].y) + (v[rr][j].z * v[rr][j].z + v[rr][j].w * v[rr][j].w); }
#pragma unroll
                for (int o = 1; o < 64; o <<= 1) { const float t0 = __shfl_xor(s1[0], o), t1 = __shfl_xor(s1[1], o); s1[0] += t0; s1[1] += t1; }
                const float r1a = rsqrtf(s1[0] * (1.f / D) + NORM_EPS), r1b = rsqrtf(s1[1] * (1.f / D) + NORM_EPS);
#pragma unroll
                for (int j = 0; j < 4; ++j) { const int k = 4 * F.lane + 256 * j;
                    const f32x4 g = *(const f32x4*)(g1p + k), ga = *(const f32x4*)(mb + 2048 + k);
#pragma unroll
                    for (int rr = 0; rr < 2; ++rr) { v[rr][j] = xnx[rr][j] + ga * (v[rr][j] * (rr ? r1b : r1a) * g);
                        s2[rr] += (v[rr][j].x * v[rr][j].x + v[rr][j].y * v[rr][j].y) + (v[rr][j].z * v[rr][j].z + v[rr][j].w * v[rr][j].w); } }
#pragma unroll
                for (int o = 1; o < 64; o <<= 1) { const float t0 = __shfl_xor(s2[0], o), t1 = __shfl_xor(s2[1], o); s2[0] += t0; s2[1] += t1; }
                const float r2a = rsqrtf(s2[0] * (1.f / D) + NORM_EPS), r2b = rsqrtf(s2[1] * (1.f / D) + NORM_EPS);
#pragma unroll
                for (int rr = 0; rr < 2; ++rr) { const int lr = 2 * F.wave + rr, m = m0 + lr; const float rstd2 = rr ? r2b : r2a;
                    GAS v2u* x1o = (GAS v2u*)(X1 + (size_t)m * D) + F.lane;
                    GAS v2u* h2o = (GAS v2u*)(H2 + (size_t)m * D) + F.lane;
#pragma unroll
                    for (int j = 0; j < 4; ++j) { const int k = 4 * F.lane + 256 * j;
                        { v2u o; o.x = cvtpk_s(v[rr][j].x, v[rr][j].y); o.y = cvtpk_s(v[rr][j].z, v[rr][j].w); __builtin_nontemporal_store(o, &x1o[64 * j]); }
                        const f32x4 g = *(const f32x4*)(g2 + k), sh = *(const f32x4*)(mb + 3072 + k), sc = *(const f32x4*)(mb + 4096 + k);
                        const f32x4 hv = v[rr][j] * rstd2 * g * (sc + 1.0f) + sh;
                        v2u hh; hh.x = cvtpk_s(hv.x, hv.y); hh.y = cvtpk_s(hv.z, hv.w); h2o[64 * j] = hh;
                        const f32x4 lo = hv - (f32x4){bflo(hh.x), bfhi(hh.x), bflo(hh.y), bfhi(hh.y)};
                        v2u ll; ll.x = cvtpk_s(lo.x, lo.y); ll.y = cvtpk_s(lo.z, lo.w);
                        *(LAS v2u*)(Ahi + lr * APITCH + 2 * k) = hh; *(LAS v2u*)(Alo + lr * APITCH + 2 * k) = ll; } }
            }
            bf16x8 rbl[4][3];
#pragma unroll
            for (int ks = 0; ks < 4; ++ks)
#pragma unroll
                for (int nt = 0; nt < 3; ++nt) rbl[ks][nt] = *(const GAS bf16x8*)(WrT + 48 * 1024 + (size_t)(16 * nt + r16) * 1024 + 128 * F.wave + 32 * ks + 8 * q4);
            if (grp + F.G < ngrp) P6_FETCH(grp + F.G);
            __syncthreads();
            {
                f32x4 acc[3];
#pragma unroll
                for (int nt = 0; nt < 3; ++nt) acc[nt] = (f32x4){0.f, 0.f, 0.f, 0.f};
#pragma unroll
                for (int ks = 0; ks < 4; ++ks) { const int k0 = 128 * F.wave + 32 * ks + 8 * q4;
                    const bf16x8 ah = *(const LAS bf16x8*)(Ahi + r16 * APITCH + 2 * k0), al = *(const LAS bf16x8*)(Alo + r16 * APITCH + 2 * k0);
#pragma unroll
                    for (int nt = 0; nt < 3; ++nt) { const bf16x8 bh = rbh[ks][nt], bl = rbl[ks][nt];
                        acc[nt] = __builtin_amdgcn_mfma_f32_16x16x32_bf16(ah, bh, acc[nt], 0, 0, 0);
                        acc[nt] = __builtin_amdgcn_mfma_f32_16x16x32_bf16(al, bh, acc[nt], 0, 0, 0);
                        acc[nt] = __builtin_amdgcn_mfma_f32_16x16x32_bf16(ah, bl, acc[nt], 0, 0, 0); } }
#pragma unroll
                for (int nt = 0; nt < 3; ++nt)
#pragma unroll
                    for (int r = 0; r < 4; ++r) part[(F.wave * 16 + 4 * q4 + r) * 48 + 16 * nt + r16] = acc[nt][r];
            }
            __syncthreads();
            for (int i = F.tid; i < 16 * 48; i += 512) { float t = 0.f;
#pragma unroll
                for (int w8 = 0; w8 < 8; ++w8) t += part[w8 * 16 * 48 + i];
                red[i] = t; }
            __syncthreads();
            if (F.wave == 0) {
                if (F.lane < 16) {
                    const LAS float* rl = red + F.lane * 48;
                    float gl[4];
#pragma unroll
                    for (int i = 0; i < 4; ++i) gl[i] = rl[i] + brg[i];
                    int gi = 0; float gm = gl[0];
#pragma unroll
                    for (int i = 1; i < 4; ++i) if (gl[i] > gm) { gm = gl[i]; gi = i; }
                    float gs = 0.f;
#pragma unroll
                    for (int i = 0; i < 4; ++i) gs += __expf(gl[i] - gm);
                    const float gwt = 1.0f / gs;
                    float el[8];
#pragma unroll
                    for (int i = 0; i < 8; ++i) el[i] = rl[4 + gi * 8 + i] + bre[gi * 8 + i];
                    int i1 = 0; float m1 = el[0];
#pragma unroll
                    for (int i = 1; i < 8; ++i) if (el[i] > m1) { m1 = el[i]; i1 = i; }
                    int i2 = -1; float m2 = -3.0e38f;
#pragma unroll
                    for (int i = 0; i < 8; ++i) if (i != i1 && el[i] > m2) { m2 = el[i]; i2 = i; }
                    const float rq = __expf(m2 - m1), w1 = 1.0f / (1.0f + rq), w2 = rq * w1;
                    const int tgt = 16 * (nstep & 3) + F.lane;
                    red[16 * 48 + tgt * 5 + 0] = __builtin_bit_cast(float, m0 + F.lane); red[16 * 48 + tgt * 5 + 1] = __builtin_bit_cast(float, gi * 8 + i1); red[16 * 48 + tgt * 5 + 2] = __builtin_bit_cast(float, gi * 8 + i2);
                    red[16 * 48 + tgt * 5 + 3] = gwt * w1; red[16 * 48 + tgt * 5 + 4] = gwt * w2;
                }
                ++nstep;
                const bool lastgrp = (grp + F.G >= ngrp);
                if ((nstep & 3) == 0 || lastgrp) {
                    LDS_WAIT(); asm volatile("" ::: "memory");
                    const int nval = ((nstep & 3) == 0) ? 64 : 16 * (nstep & 3);
                    const bool valid = F.lane < nval;
                    const LAS float* pr = red + 16 * 48 + F.lane * 5;
                    my_m = valid ? __builtin_bit_cast(int, pr[0]) : -1; my_e1 = valid ? __builtin_bit_cast(int, pr[1]) : 0; my_e2 = valid ? __builtin_bit_cast(int, pr[2]) : 0;
                    my_w1 = __builtin_bit_cast(int, pr[3]); my_w2 = __builtin_bit_cast(int, pr[4]);
                    const unsigned long long lt = (1ull << F.lane) - 1ull;
                    int r1 = 0, r2 = 0, ncnt = 0;
                    for (int e = 0; e < NEXP; ++e) {
                        const unsigned long long m1b = __ballot(valid && my_e1 == e), m2b = __ballot(valid && my_e2 == e);
                        const int c1 = __popcll(m1b), c2 = __popcll(m2b);
                        if (my_e1 == e) r1 = __popcll(m1b & lt);
                        if (my_e2 == e) r2 = c1 + __popcll(m2b & lt);
                        if (F.lane == e) ncnt = c1 + c2;
                    }
                    int base = 0;
                    if (F.lane < NEXP && ncnt > 0) base = (int)__hip_atomic_fetch_add(ecnt + F.lane, (unsigned)ncnt, __ATOMIC_RELAXED, __HIP_MEMORY_SCOPE_AGENT);
                    const int b1 = __shfl(base, my_e1), b2 = __shfl(base, my_e2);
                    if (valid) { list2[(size_t)my_e1 * M + b1 + r1] = (v2i){my_m * 2, my_w1}; list2[(size_t)my_e2 * M + b2 + r2] = (v2i){my_m * 2 + 1, my_w2};
                        tokpos[(size_t)my_m * 2] = (v2i){(my_e1 << 20) | (b1 + r1), my_w1}; tokpos[(size_t)my_m * 2 + 1] = (v2i){(my_e2 << 20) | (b2 + r2), my_w2}; }
                    if ((nstep & 3) != 0) nstep = (nstep + 3) & ~3;
                }
            }
        }
#undef P6_FETCH
        if (BOTH(6)) GRID_BAR();
    }

    LAS int* pref = (LAS int*)(F.lds + TAB_OFF); LAS int* cntl = pref + 40; LAS int* utab = (LAS int*)(F.lds + TAB_OFF + 512);
    if (IN(7) || IN(8)) {
        __syncthreads();
        if (F.tid < NEXP) cntl[F.tid] = (int)__hip_atomic_load(ecnt + F.tid, RLX_AGENT);
        __syncthreads();
        if (F.tid == 0) { int p = 0; for (int e = 0; e < NEXP; ++e) { pref[e] = p; p += (cntl[e] + 255) >> 8; } pref[NEXP] = p; }
        __syncthreads();
    }
    if (IN(7)) _Pragma("unroll") for (int rep_ = 0; rep_ < REPS(7); ++rep_) {
        F.lane = lane_id_v(); F.tid = F.wave * 64 + F.lane;
        const int U7 = pref[NEXP] * 2, RM7 = FLOWSEAM ? U7 / F.G : (1 << 20);
        pg8::GroupOrder S{pref, cntl, 2, F.G, F.vcu, M, 0, 1 << 20, F.G, RM7, nullptr, 0, 0, 0};
        { pg8::Unit u; for (int j = 0; j < 8 && S.next(j, u); ++j) { if (F.tid < 256) utab[j * 256 + F.tid] = (F.tid < u.nvalid) ? (list2[(size_t)u.lb + F.tid].x >> 1) : 0; } }
        __syncthreads();
        pg8::GatherProb P{(const char*)H2, (const char*)Wgu_t, D, utab};
        pg8::EpiGateUp E{ACT, F.lds + CS_OFF + F.wave * 2048};
        pg8::gemm_phase2<pg8::GatherProb, pg8::EpiGateUp, pg8::GroupOrder, true, true>(F.lds + RING_OFF, P, S, E, F.wave);
        if (BOTH(7)) GRID_BAR();
    }

    if (IN(8)) _Pragma("unroll") for (int rep_ = 0; rep_ < REPS(8); ++rep_) {
        F.lane = lane_id_v(); F.tid = F.wave * 64 + F.lane;
        const int U7 = pref[NEXP] * 2, RM7 = FLOWSEAM ? U7 / F.G : (1 << 20), TC7 = FLOWSEAM ? U7 - RM7 * F.G : 0;
        unsigned* flow = (unsigned*)(F.ctl + CW_FLOW);
        if (FLOWSEAM && F.vcu < TC7) {
            pg8::GroupOrder S{pref, cntl, 2, F.G, F.vcu, M, RM7 * F.G, 1 << 20, F.G, 1, flow, 1, 0, 0};
            { pg8::Unit u; if (S.next(0, u)) { if (F.tid < 256) utab[F.tid] = (F.tid < u.nvalid) ? (list2[(size_t)u.lb + F.tid].x >> 1) : 0; } }
            __syncthreads();
            pg8::GatherProb P{(const char*)H2, (const char*)Wgu_t, D, utab};
            pg8::EpiGateUp E{ACT, F.lds + CS_OFF + F.wave * 2048};
            pg8::gemm_phase2<pg8::GatherProb, pg8::EpiGateUp, pg8::GroupOrder, true, true>(F.lds + RING_OFF, P, S, E, F.wave);
        }
        const int U8 = pref[NEXP] * 4, R8 = (U8 + F.G - 1) / F.G; const bool drop = TC7 > 0 && TC7 * 4 <= F.G;
        const int c2 = (F.vcu - TC7 + F.G) % F.G;
        pg8::GroupOrder S{pref, cntl, 4, F.G, c2, M, 0, drop ? (R8 > 4 ? R8 - 4 : 0) : (1 << 20), F.G - TC7, 1 << 20, flow, TC7 > 0 ? 2 : 0, 2, (RM7 * F.G) / 2};
        pg8::DownProb P{(const char*)ACT, (const char*)Wd_t, FF};
        pg8::EpiFp8 E{Y8, F.lds + CS_OFF + F.wave * 2048};
        pg8::gemm_phase2<pg8::DownProb, pg8::EpiFp8, pg8::GroupOrder, true, true>(F.lds + RING_OFF, P, S, E, F.wave);
        if (BOTH(8)) GRID_BAR();
    }

    if (IN(9)) _Pragma("unroll") for (int rep_ = 0; rep_ < REPS(9); ++rep_) {
        F.lane = lane_id_v(); F.tid = F.wave * 64 + F.lane;
        if (!IN(7) && !IN(8)) {
            __syncthreads();
            if (F.tid < NEXP) cntl[F.tid] = (int)__hip_atomic_load(ecnt + F.tid, RLX_AGENT);
            __syncthreads();
            if (F.tid == 0) { int p = 0; for (int e = 0; e < NEXP; ++e) { pref[e] = p; p += (cntl[e] + 255) >> 8; } pref[NEXP] = p; }
            __syncthreads();
        }
        const float* g4 = args.in[5];
        unsigned yn0[4], yn1[4]; v2u xn[4]; float wn0 = 0.f, wn1 = 0.f;
        v2i tp0 = (v2i){0, 0}, tp1 = tp0;
#define P9_TOK(mm) do { tp0 = tokpos[(size_t)(mm) * 2]; tp1 = tokpos[(size_t)(mm) * 2 + 1]; } while (0)
#define P9_FETCH(mm) do { const int wb0_ = tp0.y, wb1_ = tp1.y; \
            wn0 = __builtin_bit_cast(float, wb0_) * 0.0625f; wn1 = __builtin_bit_cast(float, wb1_) * 0.0625f; \
            const size_t r0_ = (size_t)pref[tp0.x >> 20] * 256 + (tp0.x & 0xfffff), r1_ = (size_t)pref[tp1.x >> 20] * 256 + (tp1.x & 0xfffff); \
            const GAS unsigned* y0_ = (const GAS unsigned*)(Y8 + r0_ * 1024) + F.lane; const GAS unsigned* y1_ = (const GAS unsigned*)(Y8 + r1_ * 1024) + F.lane; const GAS v2u* x_ = (const GAS v2u*)(X1 + (size_t)(mm) * D) + F.lane; \
            _Pragma("unroll") for (int j = 0; j < 4; ++j) { yn0[j] = __builtin_nontemporal_load(&y0_[64 * j]); yn1[j] = __builtin_nontemporal_load(&y1_[64 * j]); xn[j] = __builtin_nontemporal_load(&x_[64 * j]); } } while (0)
        if (gw < M) { P9_TOK(gw); P9_FETCH(gw); }
        if (gw + NGW < M) P9_TOK(gw + NGW);
        for (int m = gw; m < M; m += NGW) {
            const int b = m / T; const float* mb = mod + b * 6144 + 5120;
            unsigned ya[4], yb[4]; v2u xu4[4]; const float w0 = wn0, w1 = wn1;
#pragma unroll
            for (int j = 0; j < 4; ++j) { ya[j] = yn0[j]; yb[j] = yn1[j]; xu4[j] = xn[j]; }
            if (m + NGW < M) P9_FETCH(m + NGW);
            if (m + 2 * NGW < M) P9_TOK(m + 2 * NGW);
            f32x4 v[4]; float s = 0.f;
#pragma unroll
            for (int j = 0; j < 4; ++j) { const int a = (int)ya[j], c = (int)yb[j];
                v[j] = (f32x4){__builtin_amdgcn_cvt_f32_fp8(a, 0), __builtin_amdgcn_cvt_f32_fp8(a, 1), __builtin_amdgcn_cvt_f32_fp8(a, 2), __builtin_amdgcn_cvt_f32_fp8(a, 3)} * w0
                     + (f32x4){__builtin_amdgcn_cvt_f32_fp8(c, 0), __builtin_amdgcn_cvt_f32_fp8(c, 1), __builtin_amdgcn_cvt_f32_fp8(c, 2), __builtin_amdgcn_cvt_f32_fp8(c, 3)} * w1;
                s += (v[j].x * v[j].x + v[j].y * v[j].y) + (v[j].z * v[j].z + v[j].w * v[j].w); }
            const float rstd = rsqrtf(wave_sum(s) * (1.f / D) + NORM_EPS);
            GAS f32x4* orow = (GAS f32x4*)(args.out + (size_t)m * D) + F.lane;
#pragma unroll
            for (int j = 0; j < 4; ++j) { const int k = 4 * F.lane + 256 * j; const v2u xu = xu4[j];
                const f32x4 x1v = (f32x4){bflo(xu.x), bfhi(xu.x), bflo(xu.y), bfhi(xu.y)};
                const f32x4 g = *(const f32x4*)(g4 + k), ga = *(const f32x4*)(mb + k);
                __builtin_nontemporal_store(x1v + ga * (v[j] * rstd * g), &orow[64 * j]); }
        }
#undef P9_FETCH
#undef P9_TOK
    }
#undef IN
#undef BOTH
}

extern "C" void kernel_launch(void* const* d_in, const int* in_sizes, int n_in, void* d_out, int out_size, void* d_ws, size_t ws_size, hipStream_t stream) {
    static int grid = 0;
    if (grid == 0) {
        if (n_in != 21 || in_sizes[0] != M * D || out_size != M * D || ws_size < WS_END) { fprintf(stderr, "kernel_launch: unexpected shapes (n_in %d, in0 %d, out %d, ws %zu)\n", n_in, n_in > 0 ? in_sizes[0] : -1, out_size, ws_size); grid = -1; return; }
        int dev = 0, cus = 0, per_cu = 0;
        if (hipGetDevice(&dev) != hipSuccess || hipDeviceGetAttribute(&cus, hipDeviceAttributeMultiprocessorCount, dev) != hipSuccess) { grid = -1; return; }
        if (hipFuncSetAttribute((const void*)fwd, hipFuncAttributeMaxDynamicSharedMemorySize, LDS_BYTES) != hipSuccess) { fprintf(stderr, "kernel_launch: hipFuncSetAttribute failed\n"); grid = -1; return; }
        if (hipOccupancyMaxActiveBlocksPerMultiprocessor(&per_cu, (const void*)fwd, NWAVES * 64, LDS_BYTES) != hipSuccess || per_cu < 1)
            fprintf(stderr, "kernel_launch: occupancy query reports %d workgroups per CU\n", per_cu);
        (void)hipGetLastError();
        grid = cus;
    }
    if (grid < 0) return;
    if (hipMemsetAsync((char*)d_ws + WS_CTL, 0, CTL_ZERO_BYTES, stream) != hipSuccess) return;
    Args a{};
    for (int i = 0; i < 21; ++i) a.in[i] = (const float*)d_in[i];
    a.out = (float*)d_out; a.ws = (unsigned char*)d_ws;
    if (N_LAUNCHES == 1) { a.ph_lo = 0; a.ph_hi = N_PHASES; hipLaunchKernelGGL(fwd, dim3(grid), dim3(NWAVES * 64), LDS_BYTES, stream, a); }
    else for (int li = 0; li < N_PHASES; ++li) { a.ph_lo = li; a.ph_hi = li + 1; hipLaunchKernelGGL(fwd, dim3(grid), dim3(NWAVES * 64), LDS_BYTES, stream, a); }
}
```

```cpp
#include <hip/hip_runtime.h>
#include <cstdio>
#include <cstdint>
#ifndef EPI2
#define EPI2 0
#endif
#ifndef P4DUP
#define P4DUP 0
#endif
__device__ __forceinline__ int lane_id_v() { int l; asm volatile("v_mbcnt_lo_u32_b32 %0, -1, 0\n\tv_mbcnt_hi_u32_b32 %0, -1, %0" : "=v"(l)); return l; }
namespace pg8 {
#define PG8_LAS __attribute__((address_space(3)))
typedef unsigned short bf16_t;
typedef short bf16x8 __attribute__((ext_vector_type(8)));
typedef float f32x4 __attribute__((ext_vector_type(4)));
typedef unsigned u32x4 __attribute__((ext_vector_type(4)));
constexpr int BM = 256, BK = 64, HALF = 128, HTB = HALF * BK * 2  , STAGE_BYTES = 8 * HTB, NXCD = 8, WGM = 8;

__host__ __device__ __forceinline__ int lds_byte(int r, int c) { const int st = (r >> 4) * 2 + (c >> 5), rr = r & 15, cc = c & 31, ob = rr * 64 + cc * 2; return st * 1024 + (ob ^ (((ob >> 9) & 1) << 5)); }
__host__ __device__ __forceinline__ void stage_rc(int b, int& R, int& C) { const int st = b / 1024, sb = b % 1024, swz = sb ^ (((sb >> 9) & 1) << 5); R = (st >> 1) * 16 + swz / 64; C = (st & 1) * 32 + (swz % 64) / 2; }
__host__ __device__ __forceinline__ int perm32(int rho) { const int n = rho >> 4, i = rho & 15; return 8 * (i >> 2) + 4 * n + (i & 3); }

struct Unit { int pm, pn, e, nvalid, lb, j; };
struct Gemm { const bf16_t* A; const bf16_t* Bt; int M, N, K; };

struct StaticOrder {
    int nM, nN, nwg, G, c;
    __host__ __device__ void init(int M, int N, int G_, int c_) { nM = M / BM; nN = N / BM; nwg = nM * nN; G = G_; c = c_; }
    __host__ __device__ bool next(int i, Unit& u) const {
        const long L = (long)i * G + c; if (L >= nwg) return false;
        int wgid = (int)L; { const int q = nwg / NXCD, r = nwg % NXCD, xcd = wgid % NXCD, off = wgid / NXCD; wgid = (xcd < r ? xcd * (q + 1) : r * (q + 1) + (xcd - r) * q) + off; }
        const int nig = WGM * nN, gid = wgid / nig, fm = gid * WGM, gsz = (nM - fm) < WGM ? (nM - fm) : WGM;
        u.pm = fm + ((wgid % nig) % gsz); u.pn = (wgid % nig) / gsz; u.e = 0; u.nvalid = 256; u.lb = 0; u.j = i; return true;
    }
    static constexpr bool FLOW = false;
    __device__ __forceinline__ void wait_ready(const Unit&) const {}
    __device__ __forceinline__ void signal_done(int) const {}
};


__device__ __forceinline__ unsigned cvt_pk_bf16(float lo, float hi) { unsigned r; asm volatile("v_cvt_pk_bf16_f32 %0, %1, %2" : "=v"(r) : "v"(lo), "v"(hi)); return r; }
__device__ __forceinline__ float silu_f(float x) { return x * __builtin_amdgcn_rcpf(1.0f + __expf(-x)); }
struct PlainProb {
    const char* A; const char* Bt; int K;
    __device__ __forceinline__ void a_offs(const Unit& u, const int (&R)[2], const int (&C)[2], unsigned (&o)[2][2]) const {
#pragma unroll
        for (int h = 0; h < 2; ++h)
#pragma unroll
            for (int i = 0; i < 2; ++i) o[h][i] = (unsigned)((u.pm * BM + h * HALF + R[i]) * K + C[i]) * 2u; }
    __device__ __forceinline__ const char* b_ptr(const Unit& u) const { return Bt + (size_t)u.pn * BM * K * 2; }
};
struct GatherProb {
    const char* A; const char* Bt; int K; const PG8_LAS int* tok;
    __device__ __forceinline__ void a_offs(const Unit& u, const int (&R)[2], const int (&C)[2], unsigned (&o)[2][2]) const {
#pragma unroll
        for (int h = 0; h < 2; ++h)
#pragma unroll
            for (int i = 0; i < 2; ++i) o[h][i] = (unsigned)(tok[u.j * BM + h * HALF + R[i]] * K + C[i]) * 2u; }
    __device__ __forceinline__ const char* b_ptr(const Unit& u) const { return Bt + ((size_t)u.e * 512 + (size_t)u.pn * BM) * K * 2; }
};
struct DownProb {
    const char* A; const char* Bt; int K;
    __device__ __forceinline__ void a_offs(const Unit& u, const int (&R)[2], const int (&C)[2], unsigned (&o)[2][2]) const {
#pragma unroll
        for (int h = 0; h < 2; ++h)
#pragma unroll
            for (int i = 0; i < 2; ++i) o[h][i] = (unsigned)((u.pm * BM + h * HALF + R[i]) * K + C[i]) * 2u; }
    __device__ __forceinline__ const char* b_ptr(const Unit& u) const { return Bt + ((size_t)u.e * 1024 + (size_t)u.pn * BM) * K * 2; }
};
struct GroupOrder {
    const PG8_LAS int* pref; const PG8_LAS int* cnt; int npn, G, c, lbstride;
    int Lbase, icut, G2, imax;
    unsigned* flow; int mode  , need, rt0;
    static constexpr bool FLOW = true;
    __device__ __forceinline__ void wait_ready(const Unit& u) const {
        if (mode == 2 && u.pm >= rt0) { while (__hip_atomic_load(flow + u.pm, __ATOMIC_RELAXED, __HIP_MEMORY_SCOPE_AGENT) < (unsigned)need) __builtin_amdgcn_s_sleep(4);
            __builtin_amdgcn_fence(__ATOMIC_ACQUIRE, "agent"); }
    }
    __device__ __forceinline__ void signal_done(int pm) const {
        if (mode == 1) { __builtin_amdgcn_fence(__ATOMIC_RELEASE, "agent"); if (lane_id_v() == 0) __hip_atomic_fetch_add(flow + pm, 1u, __ATOMIC_RELAXED, __HIP_MEMORY_SCOPE_AGENT); }
    }
    __device__ __forceinline__ bool next(int i, Unit& u) const {
        if (i >= imax || (i >= icut && c >= G2)) return false;
        const int L = Lbase + (i < icut ? i * G : icut * G + (i - icut) * G2) + c; const int total = __builtin_amdgcn_readfirstlane(pref[32]) * npn; if (L >= total) return false;
        const int tix = L / npn; u.pn = L - tix * npn; u.pm = tix;
        int e = 0;
        for (int k = 1; k < 32; ++k) e += (tix >= pref[k]) ? 1 : 0;
        e = __builtin_amdgcn_readfirstlane(e);
        const int tile = tix - __builtin_amdgcn_readfirstlane(pref[e]); const int nv = __builtin_amdgcn_readfirstlane(cnt[e]) - tile * BM;
        u.e = e; u.nvalid = nv < BM ? nv : BM; u.lb = e * lbstride + tile * BM; u.j = i; return true;
    }
};
struct EpiBf16S {
    static constexpr bool PERM = true, PERM2 = false; static constexpr int MIN_STORES = 16;
    bf16_t* O; int ldc;
    __device__ __forceinline__ void operator()(const f32x4 (&acc)[2][2][4][2], const Unit& u, int wr, int wc, int fr, int fq) const {
        const int row0 = u.pm * BM + wr * 64 + fr; const int col0 = u.pn * BM + wc * 32 + 8 * fq;
#pragma unroll
        for (int ai = 0; ai < 2; ++ai)
#pragma unroll
            for (int m = 0; m < 4; ++m) { bf16_t* rowp = O + (size_t)(row0 + ai * HALF + m * 16) * ldc + col0;
#pragma unroll
                for (int bj = 0; bj < 2; ++bj) { const f32x4 v0 = acc[ai][bj][m][0], v1 = acc[ai][bj][m][1];
                    u32x4 w; w.x = cvt_pk_bf16(v0[0], v0[1]); w.y = cvt_pk_bf16(v0[2], v0[3]); w.z = cvt_pk_bf16(v1[0], v1[1]); w.w = cvt_pk_bf16(v1[2], v1[3]);
                    *(u32x4*)(rowp + bj * HALF) = w; } }
    }
};

__device__ __forceinline__ int cs_w128(int fr, int fq, int bj) { return fr * 128 + (((2 * fq + bj) ^ (fr & 7)) << 4); }
__device__ __forceinline__ int cs_r128(int lane) { return (lane >> 3) * 128 + (((lane & 7) ^ ((lane >> 3) & 7)) << 4); }
__device__ __forceinline__ int cs_w64(int fr, int fq) { return fr * 64 + ((fq ^ ((fr >> 1) & 3)) << 4); }
__device__ __forceinline__ int cs_r64(int lane) { return (lane >> 2) * 64 + (((lane & 3) ^ ((lane >> 3) & 3)) << 4); }
struct EpiProj {
    static constexpr bool PERM = true, PERM2 = true; static constexpr int MIN_STORES = 16;
    bf16_t* O; int T; size_t ka_off, va_off, xh_off, x_sz; PG8_LAS unsigned char* cs;
    __device__ __forceinline__ void operator()(const f32x4 (&acc)[2][2][4][2], const Unit& u, int wr, int wc, int fr, int fq) const {
        const int lane = fq * 16 + fr, rr = lane >> 3, rc = lane & 7;
        const int bb = (u.pm * BM) / T;
        const int t0 = u.pm * BM - bb * T + wr * 64 + rr;
        const int c = u.pn * BM + wc * 64;
        bf16_t* p; int pitch;
        if (c < 512) { pitch = 64; p = O + (size_t)(bb * 8 + (c >> 6)) * T * 64; }
        else if (c < 768) { pitch = 64; p = O + ((c >= 640) ? va_off : ka_off) + (size_t)(bb * 2 + (((c - 512) >> 6) & 1)) * T * 64; }
        else { const int cc = c - 768; pitch = 128; p = O + xh_off + (size_t)(cc >> 9) * x_sz + (size_t)(cc & 127) + (size_t)(bb * 4 + ((cc >> 7) & 3)) * T * 128; }
        p += (size_t)t0 * pitch + rc * 8;
        PG8_LAS unsigned char* w0p = cs + cs_w128(fr, fq, 0); PG8_LAS unsigned char* w1p = cs + cs_w128(fr, fq, 1); const PG8_LAS unsigned char* rp_ = cs + cs_r128(lane);
        u32x4 r0[3], r1[3];
#pragma unroll
        for (int st = 0; st < 10; ++st) {
            if (st < 8) { const int ai = st >> 2, m = st & 3;
#pragma unroll
                for (int bj = 0; bj < 2; ++bj) { const f32x4 v0 = acc[ai][bj][m][0], v1 = acc[ai][bj][m][1];
                    u32x4 w; w.x = cvt_pk_bf16(v0[0], v0[1]); w.y = cvt_pk_bf16(v0[2], v0[3]); w.z = cvt_pk_bf16(v1[0], v1[1]); w.w = cvt_pk_bf16(v1[2], v1[3]);
                    *(PG8_LAS u32x4*)(bj ? w1p : w0p) = w; }
                r0[st % 3] = *(const PG8_LAS u32x4*)rp_; r1[st % 3] = *(const PG8_LAS u32x4*)(rp_ + 1024); }
            if (st >= 2) { const int so = st - 2, ai = so >> 2, m = so & 3; bf16_t* rp = p + (size_t)((ai * HALF + m * 16) * pitch);
                *(u32x4*)rp = r0[so % 3]; *(u32x4*)(rp + (size_t)(8 * pitch)) = r1[so % 3]; }
        }
    }
};

struct EpiFp8 {
    static constexpr bool PERM = true, PERM2 = true; static constexpr int MIN_STORES = 8;
    unsigned char* O; PG8_LAS unsigned char* cs;
    __device__ __forceinline__ void operator()(const f32x4 (&acc)[2][2][4][2], const Unit& u, int wr, int wc, int fr, int fq) const {
        const int lane = lane_id_v(), rr = lane >> 2, rc = lane & 3;
        unsigned char* p = O + (size_t)(u.pm * BM + wr * 64 + rr) * 1024 + u.pn * BM + wc * 64 + rc * 16;
        PG8_LAS unsigned char* wp = cs + cs_w64(lane & 15, lane >> 4); const PG8_LAS unsigned char* rp_ = cs + cs_r64(lane);
        u32x4 rb[3];
#pragma unroll
        for (int st = 0; st < 10; ++st) {
            if (st < 8) { const int ai = st >> 2, m = st & 3; int w[4];
#pragma unroll
                for (int bj = 0; bj < 2; ++bj) { const f32x4 v0 = acc[ai][bj][m][0] * 16.0f, v1 = acc[ai][bj][m][1] * 16.0f;
                    int w0 = 0, w1 = 0;
                    w0 = __builtin_amdgcn_cvt_pk_fp8_f32(v0[0], v0[1], w0, false); w0 = __builtin_amdgcn_cvt_pk_fp8_f32(v0[2], v0[3], w0, true);
                    w1 = __builtin_amdgcn_cvt_pk_fp8_f32(v1[0], v1[1], w1, false); w1 = __builtin_amdgcn_cvt_pk_fp8_f32(v1[2], v1[3], w1, true);
                    w[2 * bj] = w0; w[2 * bj + 1] = w1; }
                const u32x4 wv = {(unsigned)w[0], (unsigned)w[1], (unsigned)w[2], (unsigned)w[3]};
                *(PG8_LAS u32x4*)wp = wv;
                rb[st % 3] = *(const PG8_LAS u32x4*)rp_; }
            if (st >= 2) { const int so = st - 2, ai = so >> 2, m = so & 3; *(u32x4*)(p + (size_t)(ai * HALF + m * 16) * 1024) = rb[so % 3]; }
        }
    }
};

struct EpiBf16W {
    static constexpr bool PERM = true, PERM2 = true; static constexpr int MIN_STORES = 16;
    bf16_t* O; int ldc; PG8_LAS unsigned char* cs;
    __device__ __forceinline__ void operator()(const f32x4 (&acc)[2][2][4][2], const Unit& u, int wr, int wc, int fr, int fq) const {
        const int lane = fq * 16 + fr, rr = lane >> 3, rc = lane & 7;
        bf16_t* p = O + (size_t)(u.pm * BM + wr * 64 + rr) * ldc + u.pn * BM + wc * 64 + rc * 8;
        PG8_LAS unsigned char* w0p = cs + cs_w128(fr, fq, 0); PG8_LAS unsigned char* w1p = cs + cs_w128(fr, fq, 1); const PG8_LAS unsigned char* rp_ = cs + cs_r128(lane);
        u32x4 r0[3], r1[3];
#pragma unroll
        for (int st = 0; st < 10; ++st) {
            if (st < 8) { const int ai = st >> 2, m = st & 3;
#pragma unroll
                for (int bj = 0; bj < 2; ++bj) { const f32x4 v0 = acc[ai][bj][m][0], v1 = acc[ai][bj][m][1];
                    u32x4 w; w.x = cvt_pk_bf16(v0[0], v0[1]); w.y = cvt_pk_bf16(v0[2], v0[3]); w.z = cvt_pk_bf16(v1[0], v1[1]); w.w = cvt_pk_bf16(v1[2], v1[3]);
                    *(PG8_LAS u32x4*)(bj ? w1p : w0p) = w; }
                r0[st % 3] = *(const PG8_LAS u32x4*)rp_; r1[st % 3] = *(const PG8_LAS u32x4*)(rp_ + 1024); }
            if (st >= 2) { const int so = st - 2, ai = so >> 2, m = so & 3; bf16_t* rowp = p + (size_t)(ai * HALF + m * 16) * ldc;
                *(u32x4*)rowp = r0[so % 3]; *(u32x4*)(rowp + (size_t)8 * ldc) = r1[so % 3]; }
        }
    }
};
struct EpiGateUp {
    static constexpr bool PERM = true, PERM2 = false; static constexpr int MIN_STORES = 8;
    bf16_t* ACT; PG8_LAS unsigned char* cs;
    __device__ __forceinline__ void operator()(const f32x4 (&acc)[2][2][4][2], const Unit& u, int wr, int wc, int fr, int fq) const {
        const int lane = lane_id_v(), rr = lane >> 2, rc = lane & 3;
        bf16_t* p = ACT + (size_t)(u.pm * BM + wr * 64 + rr) * 256 + u.pn * HALF + wc * 32 + rc * 8;
        PG8_LAS unsigned char* wp = cs + cs_w64(lane & 15, lane >> 4); const PG8_LAS unsigned char* rp_ = cs + cs_r64(lane);
        u32x4 rb[3];
#pragma unroll
        for (int st = 0; st < 10; ++st) {
            if (st < 8) { const int ai = st >> 2, m = st & 3;
                const f32x4 g0 = acc[ai][0][m][0], g1 = acc[ai][0][m][1], u0 = acc[ai][1][m][0], u1 = acc[ai][1][m][1];
                u32x4 w; w.x = cvt_pk_bf16(silu_f(g0[0]) * u0[0], silu_f(g0[1]) * u0[1]); w.y = cvt_pk_bf16(silu_f(g0[2]) * u0[2], silu_f(g0[3]) * u0[3]);
                w.z = cvt_pk_bf16(silu_f(g1[0]) * u1[0], silu_f(g1[1]) * u1[1]); w.w = cvt_pk_bf16(silu_f(g1[2]) * u1[2], silu_f(g1[3]) * u1[3]);
                *(PG8_LAS u32x4*)wp = w;
                rb[st % 3] = *(const PG8_LAS u32x4*)rp_; }
            if (st >= 2) { const int so = st - 2, ai = so >> 2, m = so & 3; *(u32x4*)(p + (size_t)(ai * HALF + m * 16) * 256) = rb[so % 3]; }
        }
    }
};
struct EpiDown {
    static constexpr bool PERM = true, PERM2 = false; static constexpr int MIN_STORES = 0;
    bf16_t* Y; const PG8_LAS int* ent;
    __device__ __forceinline__ void operator()(const f32x4 (&acc)[2][2][4][2], const Unit& u, int wr, int wc, int fr, int fq) const {
        const int col0 = u.pn * BM + wc * 32 + 8 * fq;
#pragma unroll
        for (int ai = 0; ai < 2; ++ai)
#pragma unroll
            for (int m = 0; m < 4; ++m) { const int r = ai * HALF + wr * 64 + m * 16 + fr;
                const int dest = ent[(u.j * BM + r) * 2]; const float wt = __builtin_bit_cast(float, ent[(u.j * BM + r) * 2 + 1]);
                if (r < u.nvalid) { bf16_t* rowp = Y + (size_t)dest * 1024 + col0;
#pragma unroll
                    for (int bj = 0; bj < 2; ++bj) { const f32x4 v0 = acc[ai][bj][m][0] * wt, v1 = acc[ai][bj][m][1] * wt;
                        u32x4 w; w.x = cvt_pk_bf16(v0[0], v0[1]); w.y = cvt_pk_bf16(v0[2], v0[3]); w.z = cvt_pk_bf16(v1[0], v1[1]); w.w = cvt_pk_bf16(v1[2], v1[3]);
                        *(u32x4*)(rowp + bj * HALF) = w; } } }
    }
};
template <class Prob, class Epi, class Sched, bool ALIGN_EPI = false, bool POSTEPI = false>
__device__ __forceinline__ void gemm_phase2(PG8_LAS unsigned char* lds, const Prob& P, const Sched& S, const Epi& E, int wid  ) {
    constexpr bool SP2 = true;
    const int lane = lane_id_v(), tid = wid * 64 + lane, wr = wid >> 2, wc = wid & 3, fr = lane & 15, fq = lane >> 4;
    const int K = P.K, nt = K / BK;
    unsigned voffB[2];
#pragma unroll
    for (int i = 0; i < 2; ++i) { int R, C; stage_rc(tid * 16 + i * 8192, R, C);
        int Rb = Epi::PERM ? ((R & ~31) + perm32(R & 31)) : R;
        if (Epi::PERM2) Rb = (R >> 5) * 64 + ((R >> 2) & 3) * 16 + ((R >> 4) & 1) * 4 + (R & 3);
        voffB[i] = (unsigned)(Rb * K + C) * 2u; }
    const unsigned hstepB = Epi::PERM2 ? 8u * K * 2 : (unsigned)HALF * K * 2;
#define PG8_AOFFS(unit, dst) do { int RA_[2], CA_[2]; _Pragma("unroll") for (int i_ = 0; i_ < 2; ++i_) stage_rc(tid * 16 + i_ * 8192, RA_[i_], CA_[i_]); P.a_offs(unit, RA_, CA_, dst); } while (0)
    const unsigned kstep = BK * 2;
    const unsigned ldsw = (unsigned)wid * 1024u;
    const int aoff = lds_byte(wr * 64 + fr, fq * 8), boff = lds_byte(wc * 32 + fr, fq * 8);
#define PG8_SA(b, h) (((b) * 2 + (h)) * HTB)
#define PG8_SB(b, h) ((4 + (b) * 2 + (h)) * HTB)
#define PG8_STAGE(bufoff, RS, soff, voff) do { _Pragma("unroll") for (int _i = 0; _i < 2; ++_i) \
        __builtin_amdgcn_raw_ptr_buffer_load_lds(RS, (PG8_LAS void*)(lds + (bufoff) + ldsw + _i * 8192), 16, (int)(voff)[_i], (int)(soff), 0, 0); } while (0)
#define PG8_STAGE_SEL(bufoff, RS, soff, sel, vA, vB) do { _Pragma("unroll") for (int _i = 0; _i < 2; ++_i) \
        __builtin_amdgcn_raw_ptr_buffer_load_lds(RS, (PG8_LAS void*)(lds + (bufoff) + ldsw + _i * 8192), 16, (int)((sel) ? (vA)[_i] : (vB)[_i]), (int)(soff), 0, 0); } while (0)
#define PG8_LDA(dst, b, h) do { _Pragma("unroll") for (int m = 0; m < 4; ++m) _Pragma("unroll") for (int k = 0; k < 2; ++k) dst[m][k] = *(const PG8_LAS bf16x8*)(lds + PG8_SA(b, h) + aoff + m * 2048 + k * 1024); } while (0)
#define PG8_LDB(dst, b, h) do { _Pragma("unroll") for (int n = 0; n < 2; ++n) _Pragma("unroll") for (int k = 0; k < 2; ++k) dst[n][k] = *(const PG8_LAS bf16x8*)(lds + PG8_SB(b, h) + boff + n * 2048 + k * 1024); } while (0)
#define PG8_MMA(ai, bj, At, Bt) do { __builtin_amdgcn_s_setprio(1); _Pragma("unroll") for (int m = 0; m < 4; ++m) _Pragma("unroll") for (int n = 0; n < 2; ++n) _Pragma("unroll") for (int k = 0; k < 2; ++k) \
        acc[ai][bj][m][n] = __builtin_amdgcn_mfma_f32_16x16x32_bf16(Bt[n][k], At[m][k], acc[ai][bj][m][n], 0, 0, 0); __builtin_amdgcn_s_setprio(0); } while (0)
#define PG8_WAIT_V(n) asm volatile("s_waitcnt vmcnt(" #n ")" ::: "memory")
#define PG8_WAIT_VS(pe) do { if constexpr ((pe) && Epi::MIN_STORES >= 16) PG8_WAIT_V(24); else if constexpr ((pe) && Epi::MIN_STORES >= 8) PG8_WAIT_V(16); else PG8_WAIT_V(8); } while (0)
#define PG8_WAIT_L(n) asm volatile("s_waitcnt lgkmcnt(" #n ")" ::: "memory")
#define PG8_BAR __builtin_amdgcn_s_barrier()
#define PG8_SCHED __builtin_amdgcn_sched_barrier(0)
#define PG8_KITER(TT, PE) do { const int t = (TT); \
            const bool last = (t == nt - 2); \
            const unsigned a1 = (unsigned)(t + 1) * kstep; \
            const unsigned a2 = last ? 0u : (unsigned)(t + 2) * kstep; const unsigned b2 = last ? nB : cB + (unsigned)(t + 2) * kstep; \
            const unsigned a3 = a2 + kstep, b3 = b2 + kstep; \
            { \
            constexpr bool pe = (PE); \
            PG8_LDB(B0, 0, 0); PG8_LDB(B1, 0, 1); PG8_SCHED; PG8_LDA(At, 0, 0); if constexpr (!pe) PG8_STAGE(PG8_SA(1, 1), rA, a1, aoc[1]); \
            PG8_WAIT_VS(pe); PG8_WAIT_L(0); PG8_BAR; PG8_MMA(0, 0, At, B0); PG8_MMA(0, 1, At, B1); PG8_BAR; PG8_SCHED; \
            PG8_LDA(At, 0, 1); PG8_STAGE(PG8_SB(0, 0), rB, b2, voffB); PG8_STAGE(PG8_SB(0, 1), rB, b2 + hstepB, voffB); PG8_STAGE_SEL(PG8_SA(0, 0), rA, a2, last, aon[0], aoc[0]); \
            PG8_WAIT_VS(pe); PG8_WAIT_L(0); PG8_BAR; PG8_MMA(1, 0, At, B0); PG8_MMA(1, 1, At, B1); PG8_BAR; PG8_SCHED; \
            PG8_LDB(B0, 1, 0); PG8_LDB(B1, 1, 1); PG8_SCHED; PG8_LDA(At, 1, 0); PG8_STAGE_SEL(PG8_SA(0, 1), rA, a2, last, aon[1], aoc[1]); \
            PG8_WAIT_VS(pe); PG8_WAIT_L(0); PG8_BAR; PG8_MMA(0, 0, At, B0); PG8_MMA(0, 1, At, B1); PG8_BAR; PG8_SCHED; \
            PG8_LDA(At, 1, 1); PG8_STAGE(PG8_SB(1, 0), rB, b3, voffB); PG8_STAGE(PG8_SB(1, 1), rB, b3 + hstepB, voffB); PG8_STAGE_SEL(PG8_SA(1, 0), rA, a3, last, aon[0], aoc[0]); \
            PG8_WAIT_V(8); PG8_WAIT_L(0); PG8_BAR; PG8_MMA(1, 0, At, B0); PG8_MMA(1, 1, At, B1); PG8_BAR; PG8_SCHED; \
            } \
        } while (0)
    Unit cur, nxt; int ui = 0;
    if (!S.next(0, cur)) return;
    if constexpr (Sched::FLOW) S.wait_ready(cur);
    int prev_pm = -1;
    f32x4 acc[2][2][4][2];
#pragma unroll
    for (int a = 0; a < 2; ++a)
#pragma unroll
        for (int b = 0; b < 2; ++b)
#pragma unroll
            for (int m = 0; m < 4; ++m)
#pragma unroll
                for (int n = 0; n < 2; ++n) acc[a][b][m][n] = (f32x4){0.f, 0.f, 0.f, 0.f};
    bf16x8 At[4][2], B0[2][2], B1[2][2];
    const __amdgpu_buffer_rsrc_t rA = __builtin_amdgcn_make_buffer_rsrc((void*)P.A, (short)0, 0x7fffffff, 0x00020000);
    const __amdgpu_buffer_rsrc_t rB = __builtin_amdgcn_make_buffer_rsrc((void*)P.Bt, (short)0, 0x7fffffff, 0x00020000);
    unsigned cB = (unsigned)(P.b_ptr(cur) - P.Bt);
    unsigned aoc[2][2], aon[2][2]; PG8_AOFFS(cur, aoc);
    if constexpr (SP2) {
        PG8_STAGE(PG8_SB(0, 0), rB, cB, voffB); PG8_STAGE(PG8_SB(0, 1), rB, cB + hstepB, voffB); PG8_STAGE(PG8_SA(0, 0), rA, 0u, aoc[0]); PG8_STAGE(PG8_SA(0, 1), rA, 0u, aoc[1]);
        if (wr == 1) PG8_BAR;
        PG8_WAIT_V(2); PG8_BAR;
        PG8_STAGE(PG8_SB(1, 0), rB, cB + kstep, voffB); PG8_STAGE(PG8_SA(1, 0), rA, kstep, aoc[0]); PG8_STAGE(PG8_SB(1, 1), rB, cB + hstepB + kstep, voffB);
        PG8_WAIT_V(6); PG8_BAR;
    }
    for (;;) {
        const bool has_next = S.next(ui + 1, nxt);
        if constexpr (Sched::FLOW) { if (has_next) S.wait_ready(nxt); }
        const unsigned nB = has_next ? (unsigned)(P.b_ptr(nxt) - P.Bt) : cB;
        if (has_next) PG8_AOFFS(nxt, aon); else { aon[0][0] = aoc[0][0]; aon[0][1] = aoc[0][1]; aon[1][0] = aoc[1][0]; aon[1][1] = aoc[1][1]; }
        if constexpr (POSTEPI) { int t0_ = 0; if (ui > 0) { PG8_KITER(0, true); t0_ = 2; }
          for (int tt_ = t0_; tt_ < nt; tt_ += 2) PG8_KITER(tt_, false); }
        else { for (int tt_ = 0; tt_ < nt; tt_ += 2) PG8_KITER(tt_, false); }
        if constexpr (Sched::FLOW) { if (prev_pm >= 0 && wid == 0) S.signal_done(prev_pm); prev_pm = cur.pm; }
        if constexpr (POSTEPI) PG8_STAGE(PG8_SA(1, 1), rA, kstep, aon[1]);
        if constexpr (ALIGN_EPI) { if (wr == 0) PG8_BAR; }
        E(acc, cur, wr, wc, fr, fq);
#if defined(EPI2) && EPI2
        asm volatile("" ::: "memory"); E(acc, cur, wr, wc, fr, fq);
#endif
        if (!has_next) break;
#pragma unroll
        for (int a = 0; a < 2; ++a)
#pragma unroll
            for (int b = 0; b < 2; ++b)
#pragma unroll
                for (int m = 0; m < 4; ++m)
#pragma unroll
                    for (int n = 0; n < 2; ++n) acc[a][b][m][n] = (f32x4){0.f, 0.f, 0.f, 0.f};
        cur = nxt; cB = nB; ++ui;
        aoc[0][0] = aon[0][0]; aoc[0][1] = aon[0][1]; aoc[1][0] = aon[1][0]; aoc[1][1] = aon[1][1];
        if constexpr (ALIGN_EPI) { if (wr == 1) PG8_BAR; }
    }
    PG8_WAIT_V(0);
    if constexpr (!ALIGN_EPI) { if (wr == 0) PG8_BAR; }
    PG8_BAR;
    if constexpr (Sched::FLOW) { if (wid == 0) S.signal_done(prev_pm); }
#undef PG8_SA
#undef PG8_SB
#undef PG8_STAGE
#undef PG8_STAGE_SEL
#undef PG8_LDA
#undef PG8_LDB
#undef PG8_MMA
#undef PG8_WAIT_V
#undef PG8_WAIT_VS
#undef PG8_AOFFS
#undef PG8_KITER
#undef PG8_WAIT_L
#undef PG8_BAR
#undef PG8_SCHED
}
}
constexpr int NWAVES = 8;
#ifndef MK_N_LAUNCHES
#define MK_N_LAUNCHES 1
#endif
constexpr int N_PHASES = 10;
constexpr int N_LAUNCHES = MK_N_LAUNCHES;
constexpr int BATCH = 8, T = 8192, D = 1024, M = BATCH * T;
constexpr int NPROJ = 2816;
constexpr int OFF_QA = 0, OFF_KA = 512, OFF_VA = 640, OFF_QH = 768, OFF_FH = 1280, OFF_IH = 1792, OFF_GH = 2304;
constexpr int NEXP = 32, FF = 256;
constexpr size_t PJ_QA = 0, PJ_KA = (size_t)M * 512, PJ_VA = (size_t)M * 640, PJ_XH = (size_t)M * 768, PJ_XSZ = (size_t)M * 512;
constexpr float NORM_EPS = 1e-6f;

constexpr size_t MiB = 1u << 20;
constexpr size_t WS_CTL = 0, CTL_ZERO_BYTES = 64 * 1024;
constexpr size_t WS_MOD = 1 * MiB;
constexpr size_t WS_LB = 1 * MiB + 256 * 1024;
constexpr size_t WS_WRT = 2 * MiB;
constexpr size_t WS_TOKPOS = 3 * MiB;
constexpr size_t WS_WIN = 4 * MiB;
constexpr size_t WS_WOUT = 10 * MiB;
constexpr size_t WS_WGU = 12 * MiB;
constexpr size_t WS_WD = 44 * MiB;
constexpr size_t WS_VT = 76 * MiB;
constexpr size_t WS_LIST = 60 * MiB;
constexpr size_t WS_H = 96 * MiB;
constexpr size_t WS_PROJ = 224 * MiB;
constexpr size_t WS_MIXIN = 576 * MiB;
constexpr size_t WS_X1 = 704 * MiB;
constexpr size_t WS_ACT = 832 * MiB;
constexpr size_t WS_Y = WS_PROJ;
constexpr size_t WS_U = 904 * MiB;
constexpr size_t WS_DSEG = 920 * MiB;
constexpr size_t WS_END = 921 * MiB;

constexpr int CW_BAR = 4096;
constexpr int CW_CNT = 8192;
constexpr int CW_FLOW = 8320;
#ifndef FLOWSEAM
#define FLOWSEAM 1
#endif

constexpr int RING_OFF = 0, RING_BYTES = 131072;
constexpr int LDS_BYTES = 163840;
constexpr int LDSCTL_OFF = LDS_BYTES - 1024, MISC_OFF = LDSCTL_OFF + 320;
constexpr int TAB_OFF = RING_BYTES;
constexpr int CS_OFF = TAB_OFF + 8704;
static_assert(CS_OFF + 8 * 2048 <= LDSCTL_OFF, "epilogue staging");
constexpr int P3_LDS_END = LDSCTL_OFF;

#define GAS __attribute__((address_space(1)))
#define LAS __attribute__((address_space(3)))
typedef unsigned short bf16;
typedef unsigned v4u __attribute__((ext_vector_type(4)));
typedef unsigned v2u __attribute__((ext_vector_type(2)));
typedef float f32x4 __attribute__((ext_vector_type(4)));
typedef int v2i __attribute__((ext_vector_type(2)));
typedef short bf16x8 __attribute__((ext_vector_type(8)));
typedef short s16x4 __attribute__((ext_vector_type(4)));
typedef float f32x16 __attribute__((ext_vector_type(16)));
typedef float f32x2_t __attribute__((ext_vector_type(2)));
typedef __bf16 bf16x2_t __attribute__((ext_vector_type(2)));
__device__ __forceinline__ unsigned cvtpk_s(float lo, float hi) { f32x2_t v = {lo, hi}; bf16x2_t b = __builtin_convertvector(v, bf16x2_t); return __builtin_bit_cast(unsigned, b); }
__device__ __forceinline__ int crow32(int r, int hf) { return (r & 3) + 8 * (r >> 2) + 4 * hf; }
typedef short v4i16_t __attribute__((ext_vector_type(4)));
__device__ __forceinline__ s16x4 vtr16(const LAS unsigned char* p) { return __builtin_bit_cast(s16x4, __builtin_amdgcn_ds_read_tr16_b64_v4i16((LAS v4i16_t*)p)); }
typedef GAS unsigned gu32;
#define RLX_AGENT __ATOMIC_RELAXED, __HIP_MEMORY_SCOPE_AGENT
#define LDS_WAIT() asm volatile("s_waitcnt lgkmcnt(0)" ::: "memory")
__device__ __forceinline__ unsigned f2bf(float f) { unsigned u = __builtin_bit_cast(unsigned, f); return (u + 0x7fffu + ((u >> 16) & 1u)) >> 16; }
__device__ __forceinline__ unsigned pk2(float lo, float hi) { return f2bf(lo) | (f2bf(hi) << 16); }
__device__ __forceinline__ float bf2f(bf16 v) { return __builtin_bit_cast(float, (unsigned)v << 16); }
__device__ __forceinline__ float bflo(unsigned u) { return __builtin_bit_cast(float, u << 16); }
__device__ __forceinline__ float bfhi(unsigned u) { return __builtin_bit_cast(float, u & 0xffff0000u); }
__device__ __forceinline__ float sigmoidf_(float x) { return 1.0f / (1.0f + __expf(-x)); }

#define XB_TMO      128
#define XB_XCNT(j)  (256  + 64 * (j))
#define XB_XSUB(j)  (1280 + 64 * (j))
#define XB_XGEN(j)  (2304 + 64 * (j))
#define XB_TOP      3328
#define XB_TOPGEN   3392
#define XCD_BAR_WORDS 3456
#define XB_SPIN_CAP (1u << 18)

__device__ __forceinline__ unsigned xb_ld(unsigned* p)              { return __hip_atomic_load(p, __ATOMIC_RELAXED, __HIP_MEMORY_SCOPE_AGENT); }
__device__ __forceinline__ unsigned xb_add(unsigned* p, unsigned v) { return __hip_atomic_fetch_add(p, v, __ATOMIC_RELAXED, __HIP_MEMORY_SCOPE_AGENT); }
__device__ __forceinline__ unsigned xb_xcc_id() { return (unsigned)__builtin_amdgcn_s_getreg((3 << 11) | 20) & 0xFu; }
#define XB_SPIN(cond, bar) do { unsigned _sp = 0; while (cond) { __builtin_amdgcn_s_sleep(1); \
    if ((++_sp & 255u) == 0u) { if (xb_ld(&(bar)[XB_TMO])) break; if (_sp > XB_SPIN_CAP) { atomicAdd(&(bar)[XB_TMO], 1u); break; } } } } while (0)

struct XcdBarrier {
    unsigned* bar; unsigned x;
    volatile LAS unsigned* st;
};

__device__ __forceinline__ XcdBarrier xcd_barrier_post(unsigned* bar, volatile LAS unsigned* st) {
    XcdBarrier b; b.bar = bar; b.x = xb_xcc_id(); b.st = st;
    if (threadIdx.x == 0) (void)xb_add(&bar[XB_XCNT(b.x)], 1u);
    return b;
}
__device__ __forceinline__ void xcd_barrier_complete(unsigned* bar, unsigned x, unsigned& nloc, unsigned& nx) {
    const unsigned G = gridDim.x * gridDim.y * gridDim.z;
    unsigned sum, cnt, mine, sp = 0u;
    for (;;) {
        sum = 0u; cnt = 0u; mine = 0u;
#pragma unroll
        for (unsigned j = 0; j < 16; ++j) { const unsigned c = xb_ld(&bar[XB_XCNT(j)]); sum += c; cnt += (c > 0u) ? 1u : 0u; mine = (j == x) ? c : mine; }
        if (sum == G) break;
        __builtin_amdgcn_s_sleep(1);
        if ((++sp & 255u) == 0u) { if (xb_ld(&bar[XB_TMO])) break; if (sp > XB_SPIN_CAP) { atomicAdd(&bar[XB_TMO], 1u); break; } }
    }
    nloc = mine > 0u ? mine : 1u; nx = cnt > 0u ? cnt : 1u;
}

__device__ __forceinline__ void xcd_barrier(const XcdBarrier& b) {
    asm volatile("s_waitcnt vmcnt(0)" ::: "memory");
    __syncthreads();
    if (threadIdx.x == 0) {
        unsigned* bar = b.bar;
        __builtin_amdgcn_s_waitcnt(0);
        unsigned nloc = b.st[0], nx = b.st[1];
        if (nloc == 0u) { xcd_barrier_complete(bar, b.x, nloc, nx); b.st[0] = nloc; b.st[1] = nx; }
        const unsigned old = xb_add(&bar[XB_XSUB(b.x)], 1u);
        const unsigned gen = old / nloc;
        if (old + 1u == (gen + 1u) * nloc) {
            __builtin_amdgcn_fence(__ATOMIC_RELEASE, "agent");
            asm volatile("s_waitcnt vmcnt(0)" ::: "memory");
            const unsigned og = xb_add(&bar[XB_TOP], 1u);
            const unsigned tg = og / nx;
            if (og + 1u == (tg + 1u) * nx) xb_add(&bar[XB_TOPGEN], 1u);
            else XB_SPIN(xb_ld(&bar[XB_TOPGEN]) == tg, bar);
            __builtin_amdgcn_fence(__ATOMIC_ACQUIRE, "agent");
            xb_add(&bar[XB_XGEN(b.x)], 1u);
            asm volatile("s_waitcnt vmcnt(0)" ::: "memory");
        } else {
            XB_SPIN(xb_ld(&bar[XB_XGEN(b.x)]) == gen, bar);
            __builtin_amdgcn_fence(__ATOMIC_ACQUIRE, "agent");
            asm volatile("s_waitcnt vmcnt(0)" ::: "memory");
        }
    }
    __syncthreads();
}


struct Frame {
    LAS unsigned char* lds;
    volatile LAS unsigned* MISC;
    gu32* ctl;
    int tid, lane, wave;
    int vcu, G;
};
__device__ __forceinline__ float wave_sum(float v) {
#pragma unroll
    for (int o = 1; o < 64; o <<= 1) v += __shfl_xor(v, o);
    return v;
}
__device__ __forceinline__ void p0_transpose_tile(const float* Wt, int N, bf16* WTt, int K, LAS float* scr, int lane) {
    float tv[32];
#pragma unroll
    for (int i = 0; i < 32; ++i) tv[i] = __builtin_nontemporal_load(&Wt[(size_t)(2 * i + (lane >> 5)) * N + (lane & 31)]);
#pragma unroll
    for (int i = 0; i < 32; ++i) scr[(2 * i + (lane >> 5)) * 33 + (lane & 31)] = tv[i];
    LDS_WAIT(); asm volatile("" ::: "memory");
    const int c = lane & 7;
#pragma unroll
    for (int j = 0; j < 4; ++j) { const int n = (lane >> 3) + 8 * j; const LAS float* s = scr + (8 * c) * 33 + n;
        v4u o; o.x = pk2(s[0 * 33], s[1 * 33]); o.y = pk2(s[2 * 33], s[3 * 33]); o.z = pk2(s[4 * 33], s[5 * 33]); o.w = pk2(s[6 * 33], s[7 * 33]);
        *(GAS v4u*)(WTt + (size_t)n * K + 8 * c) = o; }
    LDS_WAIT(); asm volatile("" ::: "memory");
}


#define HG_MFMA(a, b, c) __builtin_amdgcn_mfma_f32_16x16x32_bf16((a), (b), (c), 0, 0, 0)
namespace hg {
#ifndef HGP
#define HGP 0
#endif
constexpr int QT_OFF = 0, KT_OFF = 12288, KET_OFF = 22528, DEC_OFF = 34816, BUFSZ = 35328, SSQ_OFF = 2 * BUFSZ, RAW_OFF = SSQ_OFF + 2048, RAWSZ = 4 * 8704, OUT_OFF = RAW_OFF + 2 * RAWSZ, OUTSZ = 8704, PB_OFF = OUT_OFF + 2 * OUTSZ, LDS_NEED = PB_OFF + 2048;
constexpr int RF_OFF = 0, RQ_OFF = 8704, RV_OFF = 17408, RG_OFF = 26112;
constexpr int PT = 272, PC = 96, PCK = 80;
struct Raw { v4u f, q, v, g; };
template <bool FULL>
__device__ __forceinline__ void load_raw(Raw& R, const bf16* PROJ, size_t rowc, int h, int tid) {
    const size_t bb = rowc / T, tt = rowc - bb * T;
    const bf16* p = PROJ + PJ_XH + ((bb * 4 + h) * T + tt) * 128 + (size_t)tid * 8;
    if (FULL) { R.f = __builtin_nontemporal_load((const GAS v4u*)(p + PJ_XSZ)); R.v = __builtin_nontemporal_load((const GAS v4u*)(p + 2 * PJ_XSZ)); R.q = __builtin_nontemporal_load((const GAS v4u*)p); R.g = __builtin_nontemporal_load((const GAS v4u*)(p + 3 * PJ_XSZ)); }
    else { R.f = *(const GAS v4u*)(p + PJ_XSZ); R.v = *(const GAS v4u*)(p + 2 * PJ_XSZ); }
}
template <bool FULL>
__device__ __forceinline__ void store_raw(const Raw& R, LAS unsigned char* raw, int tid) {
    LAS unsigned char* d = raw + (tid >> 4) * PT + 16 * (tid & 15);
    *(LAS v4u*)(d + RF_OFF) = R.f; *(LAS v4u*)(d + RV_OFF) = R.v; if (FULL) { *(LAS v4u*)(d + RQ_OFF) = R.q; *(LAS v4u*)(d + RG_OFF) = R.g; }
}
__device__ __forceinline__ s16x4 vtr16(const LAS unsigned char* p) { return __builtin_bit_cast(s16x4, __builtin_amdgcn_ds_read_tr16_b64_v4i16((LAS v4i16_t*)p)); }
template <bool FULL>
__device__ __forceinline__ void prep(const LAS unsigned char* raw, LAS unsigned char* buf, float lb, int w, int r16, int q, float& Dacc) {
    const int key = 16 * w + r16;
    const LAS unsigned char* tp = raw + (8 * q + (r16 >> 2)) * PT + 32 * w + 8 * (r16 & 3);
    const v2u F0 = __builtin_bit_cast(v2u, vtr16(tp + RF_OFF)), F1 = __builtin_bit_cast(v2u, vtr16(tp + RF_OFF + 4 * PT));
    const float fx[8] = {bflo(F0.x), bfhi(F0.x), bflo(F0.y), bfhi(F0.y), bflo(F1.x), bfhi(F1.x), bflo(F1.y), bfhi(F1.y)};
    float fv[8], P[8];
#pragma unroll
    for (int i = 0; i < 8; ++i) fv[i] = lb + (1.0f - lb) * __builtin_amdgcn_rcpf(1.0f + __expf(-fx[i]));
    P[0] = fv[0];
#pragma unroll
    for (int i = 1; i < 8; ++i) P[i] = P[i - 1] * fv[i];
    const float gt = P[7];
    const float t0 = __shfl(gt, r16), t1 = __shfl(gt, r16 + 16), t2 = __shfl(gt, r16 + 32), t3 = __shfl(gt, r16 + 48);
    const float excl = (q > 0 ? t0 : 1.0f) * (q > 1 ? t1 : 1.0f) * (q > 2 ? t2 : 1.0f);
    const float Plast = (t0 * t1) * (t2 * t3);
    float ke[8], kd[8], qd[8];
    float qx[8] = {0.f, 0.f, 0.f, 0.f, 0.f, 0.f, 0.f, 0.f};
    if (FULL) { const v2u Q0 = __builtin_bit_cast(v2u, vtr16(tp + RQ_OFF)), Q1 = __builtin_bit_cast(v2u, vtr16(tp + RQ_OFF + 4 * PT));
        qx[0] = bflo(Q0.x); qx[1] = bfhi(Q0.x); qx[2] = bflo(Q0.y); qx[3] = bfhi(Q0.y); qx[4] = bflo(Q1.x); qx[5] = bfhi(Q1.x); qx[6] = bflo(Q1.y); qx[7] = bfhi(Q1.y); }
#pragma unroll
    for (int i = 0; i < 8; ++i) P[i] *= excl;
    float rP[8]; rP[7] = __builtin_amdgcn_rcpf(P[7]);
#pragma unroll
    for (int i = 7; i > 0; --i) rP[i - 1] = rP[i] * fv[i];
#pragma unroll
    for (int i = 0; i < 8; ++i) { kd[i] = (1.0f - fv[i]) * rP[i]; ke[i] = kd[i] * Plast;
        if (FULL) qd[i] = qx[i] * __builtin_amdgcn_rcpf(1.0f + __expf(-qx[i])) * P[i]; }
    *(LAS v4u*)(buf + KET_OFF + key * PC + 16 * q) = (v4u){cvtpk_s(ke[0], ke[1]), cvtpk_s(ke[2], ke[3]), cvtpk_s(ke[4], ke[5]), cvtpk_s(ke[6], ke[7])};
    if (FULL) { *(LAS v4u*)(buf + KT_OFF + key * PCK + 16 * q) = (v4u){cvtpk_s(kd[0], kd[1]), cvtpk_s(kd[2], kd[3]), cvtpk_s(kd[4], kd[5]), cvtpk_s(kd[6], kd[7])};
        *(LAS v4u*)(buf + QT_OFF + key * PC + 16 * q) = (v4u){cvtpk_s(qd[0], qd[1]), cvtpk_s(qd[2], qd[3]), cvtpk_s(qd[4], qd[5]), cvtpk_s(qd[6], qd[7])}; }
    if (q == 0) *(LAS float*)(buf + DEC_OFF + 4 * key) = Plast;
    Dacc *= Plast;
}
__device__ __forceinline__ void prep_state(const LAS unsigned char* raw, LAS unsigned char* buf, float lb, int w, int r16, int q, float& Dacc) {
    const int key = 16 * w + r16;
    const LAS unsigned char* tp = raw + (8 * q + (r16 >> 2)) * PT + 32 * w + 8 * (r16 & 3);
    const v2u F0 = __builtin_bit_cast(v2u, vtr16(tp)), F1 = __builtin_bit_cast(v2u, vtr16(tp + 4 * PT));
    const float fx[8] = {bflo(F0.x), bfhi(F0.x), bflo(F0.y), bfhi(F0.y), bflo(F1.x), bfhi(F1.x), bflo(F1.y), bfhi(F1.y)};
    float fv[8], Q[8];
#pragma unroll
    for (int i = 0; i < 8; ++i) fv[i] = lb + (1.0f - lb) * __builtin_amdgcn_rcpf(1.0f + __expf(-fx[i]));
    Q[7] = 1.0f;
#pragma unroll
    for (int i = 7; i > 0; --i) Q[i - 1] = Q[i] * fv[i];
    const float gt = Q[0] * fv[0];
    const float t0 = __shfl(gt, r16), t1 = __shfl(gt, r16 + 16), t2 = __shfl(gt, r16 + 32), t3 = __shfl(gt, r16 + 48);
    const float sfx = (q < 1 ? t1 : 1.0f) * (q < 2 ? t2 : 1.0f) * (q < 3 ? t3 : 1.0f);
    const float Plast = (t0 * t1) * (t2 * t3);
    float ke[8];
#pragma unroll
    for (int i = 0; i < 8; ++i) ke[i] = (1.0f - fv[i]) * (Q[i] * sfx);
    *(LAS v4u*)(buf + KET_OFF + key * PC + 16 * q) = (v4u){cvtpk_s(ke[0], ke[1]), cvtpk_s(ke[2], ke[3]), cvtpk_s(ke[4], ke[5]), cvtpk_s(ke[6], ke[7])};
    if (q == 0) *(LAS float*)(buf + DEC_OFF + 4 * key) = Plast;
    Dacc *= Plast;
}
#define HG_MFMA(a, b, c) __builtin_amdgcn_mfma_f32_16x16x32_bf16((a), (b), (c), 0, 0, 0)
__device__ __forceinline__ bf16x8 cat8(s16x4 lo, s16x4 hi) { return __builtin_shufflevector(lo, hi, 0, 1, 2, 3, 4, 5, 6, 7); }
__device__ __forceinline__ bf16x8 pack8(f32x4 lo, f32x4 hi) { v4u p = (v4u){cvtpk_s(lo[0], lo[1]), cvtpk_s(lo[2], lo[3]), cvtpk_s(hi[0], hi[1]), cvtpk_s(hi[2], hi[3])}; return __builtin_bit_cast(bf16x8, p); }
__device__ __forceinline__ float silu_g(float g) { return g * __builtin_amdgcn_rcpf(1.0f + __expf(-g)); }
__device__ __forceinline__ void finish(const LAS float* ssqp, f32x4 oa, f32x4 ob, v2u g0, v2u g1, f32x4 gn4, LAS unsigned char* outt, int w, int r16, int q) {
#pragma unroll
    for (int ct = 0; ct < 2; ++ct) { float tot = 0.f;
#pragma unroll
        for (int ww = 0; ww < 8; ++ww) tot += ssqp[ww * 32 + 16 * ct + r16];
        const float rstd = rsqrtf(tot * (1.f / 128.f) + NORM_EPS);
        const f32x4 o = ct ? ob : oa; const v2u gg = ct ? g1 : g0;
        const float y0 = o[0] * rstd * gn4[0] * silu_g(bflo(gg.x)), y1 = o[1] * rstd * gn4[1] * silu_g(bfhi(gg.x));
        const float y2 = o[2] * rstd * gn4[2] * silu_g(bflo(gg.y)), y3 = o[3] * rstd * gn4[3] * silu_g(bfhi(gg.y));
        *(LAS v2u*)(outt + (16 * ct + r16) * PT + 2 * (16 * w + 4 * q)) = (v2u){cvtpk_s(y0, y1), cvtpk_s(y2, y3)}; }
}
__device__ __forceinline__ void flush_out(const LAS unsigned char* outt, bf16* dst_row0, int tid) {
    *(GAS v4u*)(dst_row0 + (size_t)(tid >> 4) * D + 8 * (tid & 15)) = *(const LAS v4u*)(outt + (tid >> 4) * PT + 16 * (tid & 15));
}

__device__ __forceinline__ void atile(const LAS unsigned char* buf, LAS unsigned char* pb, int w, int l, int r16, int q) {
    if (w < 3) {
        const LAS unsigned char* ktr = buf + KT_OFF + (4 * q + (r16 >> 2)) * PCK + 8 * (r16 & 3) + (w == 2 ? 32 : 0);
        const LAS unsigned char* qtr = buf + QT_OFF + (4 * q + (r16 >> 2)) * PC + 8 * (r16 & 3) + (w >= 1 ? 32 : 0);
        f32x4 a = (f32x4){0.f, 0.f, 0.f, 0.f};
#pragma unroll
        for (int ks = 0; ks < 4; ++ks) a = HG_MFMA(cat8(vtr16(ktr + 32 * ks * PCK), vtr16(ktr + (32 * ks + 16) * PCK)), cat8(vtr16(qtr + 32 * ks * PC), vtr16(qtr + (32 * ks + 16) * PC)), a);
        if (w != 1) {
#pragma unroll
            for (int r = 0; r < 4; ++r) a[r] = ((4 * q + r) <= r16) ? a[r] : 0.f; }
        *(LAS v2u*)(pb + 32 * l + (w == 0 ? 0 : 8 + 8 * w)) = (v2u){cvtpk_s(a[0], a[1]), cvtpk_s(a[2], a[3])};
    }
}
#define HG_BAR() asm volatile("s_waitcnt lgkmcnt(0)\n\ts_barrier" ::: "memory")
#define HG_BODY(NN, RLOAD, RSTORE) do { const int n = (NN); \
        LAS unsigned char* buf = lds + (n & 1) * BUFSZ; \
        const LAS unsigned char* rawc = lds + RAW_OFF + (n & 1) * RAWSZ; \
        load_raw<FULL>(RLOAD, PROJ, row0 + 32 * (n + 3 < 32 ? n + 3 : 31), h, tid); \
        f32x4 o0 = (f32x4){0.f, 0.f, 0.f, 0.f}, o1 = o0; v2u g0 = (v2u){0u, 0u}, g1 = g0; \
        const LAS unsigned char* vtr = rawc + RV_OFF + (r16 >> 2) * PT + 32 * w + 8 * (r16 & 3); \
        if (FULL) { \
            g0 = *(const LAS v2u*)(rawc + RG_OFF + r16 * PT + 2 * (16 * w + 4 * q)); g1 = *(const LAS v2u*)(rawc + RG_OFF + (16 + r16) * PT + 2 * (16 * w + 4 * q)); \
            const LAS unsigned char* qt2 = buf + QT_OFF + (4 * q + (r16 >> 2)) * PC + 8 * (r16 & 3); \
            const v2u pa = *(const LAS v2u*)(lds + PB_OFF + 32 * l); \
            const bf16x8 pb0 = __builtin_bit_cast(bf16x8, ((v4u){pa.x, pa.y, 0u, 0u})), pb1 = *(const LAS bf16x8*)(lds + PB_OFF + 32 * l + 16); \
            const bf16x8 va = cat8(vtr16(vtr + (4 * q) * PT), vtr16(vtr + (16 + 4 * q) * PT)); \
            o0 = HG_MFMA(va, pb0, o0); o1 = HG_MFMA(va, pb1, o1); \
_Pragma("unroll") \
            for (int i = 0; i < 4; ++i) { \
                const bf16x8 sa = pack8(S[2 * i], S[2 * i + 1]); \
                const bf16x8 b0 = cat8(vtr16(qt2 + 32 * i * PC), vtr16(qt2 + (32 * i + 16) * PC)), b1 = cat8(vtr16(qt2 + 32 * i * PC + 32), vtr16(qt2 + (32 * i + 16) * PC + 32)); \
                o0 = HG_MFMA(sa, b0, o0); o1 = HG_MFMA(sa, b1, o1); } \
            float p0 = (o0[0] * o0[0] + o0[1] * o0[1]) + (o0[2] * o0[2] + o0[3] * o0[3]), p1 = (o1[0] * o1[0] + o1[1] * o1[1]) + (o1[2] * o1[2] + o1[3] * o1[3]); \
            p0 += __shfl_xor(p0, 16); p0 += __shfl_xor(p0, 32); p1 += __shfl_xor(p1, 16); p1 += __shfl_xor(p1, 32); \
            if (q == 0) { ssq[((n & 1) * 8 + w) * 32 + r16] = p0; ssq[((n & 1) * 8 + w) * 32 + 16 + r16] = p1; } \
        } \
        { \
            const bf16x8 vb = cat8(vtr16(vtr + (8 * q) * PT), vtr16(vtr + (8 * q + 4) * PT)); \
_Pragma("unroll") \
            for (int kt = 0; kt < 8; ++kt) { const f32x4 d4 = *(const LAS f32x4*)(buf + DEC_OFF + 4 * (16 * kt + 4 * q)); \
                const bf16x8 ka = *(const LAS bf16x8*)(buf + KET_OFF + (16 * kt + r16) * PC + 16 * q); \
                S[kt] = HG_MFMA(ka, vb, S[kt] * d4); } \
        } \
        HG_BAR(); \
        if (n + 1 < 32) prep<FULL>(lds + RAW_OFF + ((n + 1) & 1) * RAWSZ, lds + ((n + 1) & 1) * BUFSZ, lb, w, r16, q, Dacc); \
        if (FULL && n > 0) flush_out(lds + OUT_OFF + ((n - 1) & 1) * OUTSZ, orow + (size_t)(32 * (n - 1)) * D, tid); \
        HG_BAR(); \
        if (FULL) finish(ssq + (n & 1) * 256, o0, o1, g0, g1, gn4, lds + OUT_OFF + (n & 1) * OUTSZ, w, r16, q); \
        store_raw<FULL>(RSTORE, lds + RAW_OFF + (n & 1) * RAWSZ, tid); \
        if (FULL && n + 1 < 32) atile(lds + ((n + 1) & 1) * BUFSZ, lds + PB_OFF, w, l, r16, q); \
        HG_BAR(); \
    } while (0)
template <bool FULL, int NCH = 32>
__device__ __forceinline__ void unit(LAS unsigned char* lds, int tid, int un_, const bf16* PROJ, const float* lbv, float* Ubuf, float* Dbuf, const float* gnorm, bf16* MIXIN) {
    const int w = __builtin_amdgcn_readfirstlane(tid >> 6), l = tid & 63, r16 = l & 15, q = l >> 4;
    const int b = un_ >> 5, h = (un_ >> 3) & 3, seg = un_ & 7;
    const size_t row0 = (size_t)b * T + (size_t)seg * 1024;
    const float lb = lbv[h * 128 + 16 * w + r16];
    LAS float* ssq = (LAS float*)(lds + SSQ_OFF);
    f32x4 S[8];
#pragma unroll
    for (int kt = 0; kt < 8; ++kt) S[kt] = (f32x4){0.f, 0.f, 0.f, 0.f};
    Raw R, R1;
    load_raw<FULL>(R, PROJ, row0, h, tid);
    if (FULL) {
        f32x4 un[8], dn[8];
        if (seg > 0) { const float* Uj = Ubuf + ((size_t)(un_ - seg) * 8 + w) * 2048; const float* Dj = Dbuf + (size_t)(un_ - seg) * 128;
#pragma unroll
            for (int kt = 0; kt < 8; ++kt) { dn[kt] = *(const f32x4*)(Dj + 16 * kt + 4 * q); un[kt] = *(const f32x4*)(Uj + (kt * 64 + l) * 4); } }
        for (int j = 0; j < seg; ++j) {
            f32x4 uc[8], dc[8];
#pragma unroll
            for (int kt = 0; kt < 8; ++kt) { uc[kt] = un[kt]; dc[kt] = dn[kt]; }
            if (j + 1 < seg) { const float* Uj = Ubuf + ((size_t)(un_ - seg + j + 1) * 8 + w) * 2048; const float* Dj = Dbuf + (size_t)(un_ - seg + j + 1) * 128;
#pragma unroll
                for (int kt = 0; kt < 8; ++kt) { dn[kt] = *(const f32x4*)(Dj + 16 * kt + 4 * q); un[kt] = *(const f32x4*)(Uj + (kt * 64 + l) * 4); } }
#pragma unroll
            for (int kt = 0; kt < 8; ++kt) S[kt] = S[kt] * dc[kt] + uc[kt];
        }
    }
    float Dacc = 1.0f;
    f32x4 gn4 = (f32x4){0.f, 0.f, 0.f, 0.f};
    if (FULL) gn4 = *(const f32x4*)(gnorm + h * 128 + 16 * w + 4 * q);
    store_raw<FULL>(R, lds + RAW_OFF, tid);
    load_raw<FULL>(R, PROJ, row0 + 32, h, tid);
    __syncthreads();
    prep<FULL>(lds + RAW_OFF, lds, lb, w, r16, q, Dacc);
    store_raw<FULL>(R, lds + RAW_OFF + RAWSZ, tid);
    load_raw<FULL>(R, PROJ, row0 + 64, h, tid);
    __syncthreads();
    if (FULL) { atile(lds, lds + PB_OFF, w, l, r16, q); __syncthreads(); }
    bf16* const orow = MIXIN + row0 * D + 512 + h * 128;
    for (int n2 = 0; n2 < NCH; n2 += 2) { HG_BODY(n2, R1, R); HG_BODY(n2 + 1, R, R1); }
    if (FULL) { __syncthreads(); flush_out(lds + OUT_OFF + OUTSZ, orow + (size_t)(32 * 31) * D, tid); }
    if (!FULL) {
        float* Uo = Ubuf + ((size_t)un_ * 8 + w) * 2048;
#pragma unroll
        for (int kt = 0; kt < 8; ++kt) *(f32x4*)(Uo + (kt * 64 + l) * 4) = S[kt];
        if (q == 0) Dbuf[(size_t)un_ * 128 + 16 * w + r16] = Dacc;
    }
    __syncthreads();
}
constexpr int SP_RAWC = 2 * 8704, SP_RAWP = 2 * SP_RAWC, SP_IMG_OFF = 3 * SP_RAWP, SP_IMG = 12800, SP_NEED = SP_IMG_OFF + 4 * SP_IMG;
struct Raw2 { v4u f0, v0, f1, v1; };
__device__ __forceinline__ void sp_load(Raw2& R, const bf16* PROJ, size_t rowc, int h, int tid) {
    const size_t bb = rowc / T, tt = rowc - bb * T;
    const bf16* p = PROJ + PJ_XH + ((bb * 4 + h) * T + tt) * 128 + (size_t)tid * 8;
    R.f0 = *(const GAS v4u*)(p + PJ_XSZ); R.v0 = *(const GAS v4u*)(p + 2 * PJ_XSZ); R.f1 = *(const GAS v4u*)(p + PJ_XSZ + 32 * 128); R.v1 = *(const GAS v4u*)(p + 2 * PJ_XSZ + 32 * 128);
}
__device__ __forceinline__ void sp_store(const Raw2& R, LAS unsigned char* raw, int tid) {
    LAS unsigned char* d = raw + (tid >> 4) * PT + 16 * (tid & 15);
    *(LAS v4u*)d = R.f0; *(LAS v4u*)(d + 8704) = R.v0; *(LAS v4u*)(d + SP_RAWC) = R.f1; *(LAS v4u*)(d + SP_RAWC + 8704) = R.v1;
}
#define SP_UPD(IMGP, RAWP) do { const LAS unsigned char* im_ = (IMGP); const LAS unsigned char* vt_ = (RAWP) + 8704 + (r16 >> 2) * PT + 32 * w + 8 * (r16 & 3); \
        const bf16x8 vb = cat8(vtr16(vt_ + (8 * q) * PT), vtr16(vt_ + (8 * q + 4) * PT)); \
_Pragma("unroll") \
        for (int kt = 0; kt < 8; ++kt) { const f32x4 d4 = *(const LAS f32x4*)(im_ + 12288 + 4 * (16 * kt + 4 * q)); \
            const bf16x8 ka = *(const LAS bf16x8*)(im_ + (16 * kt + r16) * PC + 16 * q); \
            S[kt] = HG_MFMA(ka, vb, S[kt] * d4); } } while (0)
#define SP_PBUF(k) (lds + SP_IMG_OFF + (k) * SP_IMG - KET_OFF)
#define SP_STEP(MM, RLOAD, RSTORE) do { const int m = (MM), pp = m & 1; \
        sp_load(RLOAD, PROJ, row0 + 64 * (m + 3 < 16 ? m + 3 : 15), h, tid); \
        SP_UPD(lds + SP_IMG_OFF + (2 * pp) * SP_IMG, lds + o0); \
        SP_UPD(lds + SP_IMG_OFF + (2 * pp + 1) * SP_IMG, lds + o0 + SP_RAWC); \
        if (m + 1 < 16) { prep_state(lds + o1, SP_PBUF(2 * (pp ^ 1)), lb, w, r16, q, Dacc); prep_state(lds + o1 + SP_RAWC, SP_PBUF(2 * (pp ^ 1) + 1), lb, w, r16, q, Dacc); } \
        if (m + 2 < 16) sp_store(RSTORE, lds + o2, tid); \
        HG_BAR(); \
        { const int t_ = o0; o0 = o1; o1 = o2; o2 = t_; } \
    } while (0)
__device__ __forceinline__ void unit_state(LAS unsigned char* lds, int tid, int un_, const bf16* PROJ, const float* lbv, float* Ubuf, float* Dbuf) {
    const int w = __builtin_amdgcn_readfirstlane(tid >> 6), l = tid & 63, r16 = l & 15, q = l >> 4;
    const int b = un_ >> 5, h = (un_ >> 3) & 3, seg = un_ & 7;
    const size_t row0 = (size_t)b * T + (size_t)seg * 1024;
    const float lb = lbv[h * 128 + 16 * w + r16];
    f32x4 S[8];
#pragma unroll
    for (int kt = 0; kt < 8; ++kt) S[kt] = (f32x4){0.f, 0.f, 0.f, 0.f};
    float Dacc = 1.0f;
    Raw2 RA, RB;
    sp_load(RA, PROJ, row0, h, tid);
    sp_store(RA, lds, tid);
    sp_load(RA, PROJ, row0 + 64, h, tid);
    __syncthreads();
    prep_state(lds, SP_PBUF(0), lb, w, r16, q, Dacc); prep_state(lds + SP_RAWC, SP_PBUF(1), lb, w, r16, q, Dacc);
    sp_store(RA, lds + SP_RAWP, tid);
    sp_load(RA, PROJ, row0 + 128, h, tid);
    __syncthreads();
    int o0 = 0, o1 = SP_RAWP, o2 = 2 * SP_RAWP;
    for (int m2 = 0; m2 < 16; m2 += 2) { SP_STEP(m2, RB, RA); SP_STEP(m2 + 1, RA, RB); }
    float* Uo = Ubuf + ((size_t)un_ * 8 + w) * 2048;
#pragma unroll
    for (int kt = 0; kt < 8; ++kt) *(f32x4*)(Uo + (kt * 64 + l) * 4) = S[kt];
    if (q == 0) Dbuf[(size_t)un_ * 128 + 16 * w + r16] = Dacc;
    __syncthreads();
}
}

struct Args { const float* in[21]; float* out; unsigned char* ws; int ph_lo, ph_hi; };

__global__ void __launch_bounds__(NWAVES * 64, 2) fwd(Args args) {
    extern __shared__ __attribute__((aligned(16))) unsigned char lds[];
    Frame F;
    F.lds = (LAS unsigned char*)lds;
    F.MISC = (volatile LAS unsigned*)(F.lds + MISC_OFF);
    F.tid = threadIdx.x; F.lane = F.tid & 63; F.wave = __builtin_amdgcn_readfirstlane(F.tid >> 6);
    F.G = gridDim.x; { const int bx = blockIdx.x; F.vcu = (F.G % 8 == 0) ? (bx % 8) * (F.G / 8) + bx / 8 : bx; }
    unsigned char* ws = args.ws;
    F.ctl = (gu32*)(ws + WS_CTL);
    for (int u = F.tid; u < (LDS_BYTES - LDSCTL_OFF) / 4; u += NWAVES * 64) ((LAS unsigned*)(F.lds + LDSCTL_OFF))[u] = 0u;
    __syncthreads();
    XcdBarrier bar; bar.bar = (unsigned*)(F.ctl + CW_BAR); bar.x = 0; bar.st = nullptr;
    if (N_LAUNCHES == 1) bar = xcd_barrier_post((unsigned*)(F.ctl + CW_BAR), F.MISC + 8);
#define GRID_BAR() do { if (N_LAUNCHES == 1) xcd_barrier(bar); } while (0)
    const int lo = args.ph_lo, hi = args.ph_hi;
#define IN(k) (lo <= (k) && (k) < hi)
#define BOTH(k) (IN(k) && IN((k) + 1))
#ifndef REPMASK
#define REPMASK 0
#endif
#define REPS(k) ((((REPMASK) >> (k)) & 1) + 1)

    const float* x = args.in[0];
    float* mod = (float*)(ws + WS_MOD);
    float* lbv = (float*)(ws + WS_LB);
    bf16* Win_t = (bf16*)(ws + WS_WIN); bf16* Wout_t = (bf16*)(ws + WS_WOUT); bf16* Wgu_t = (bf16*)(ws + WS_WGU); bf16* Wd_t = (bf16*)(ws + WS_WD);
    bf16* WrT = (bf16*)(ws + WS_WRT);
 float* Useg = (float*)(ws + WS_U); float* Dseg = (float*)(ws + WS_DSEG);
    v2i* list2 = (v2i*)(ws + WS_LIST); v2i* tokpos = (v2i*)(ws + WS_TOKPOS); bf16* ACT = (bf16*)(ws + WS_ACT); unsigned char* Y8 = (unsigned char*)(ws + WS_Y); gu32* ecnt = F.ctl + CW_CNT;
    bf16* Hb = (bf16*)(ws + WS_H); bf16* PROJ = (bf16*)(ws + WS_PROJ); bf16* MIXIN = (bf16*)(ws + WS_MIXIN); bf16* X1 = (bf16*)(ws + WS_X1);
    bf16* MIX = Hb; bf16* H2 = MIXIN;
    const int gw = F.vcu * NWAVES + F.wave, NGW = F.G * NWAVES;

    if (IN(0)) _Pragma("unroll") for (int rep_ = 0; rep_ < REPS(0); ++rep_) {
        F.lane = lane_id_v(); F.tid = F.wave * 64 + F.lane;
        LAS float* scr = (LAS float*)(F.lds + RING_OFF + F.wave * 16384);
        constexpr int I_IN = (D / 64) * (NPROJ / 32), I_OUT = (D / 64) * (D / 32), I_G = NEXP * (D / 64) * (FF / 32), I_D = NEXP * (FF / 64) * (D / 32);
        for (int it = gw; it < I_IN + I_OUT + 2 * I_G + I_D; it += NGW) {
            int r = it;
            if (r < I_IN) { const int nblk = NPROJ / 32, k0 = 64 * (r / nblk), n0 = 32 * (r % nblk);
                p0_transpose_tile(args.in[8] + (size_t)k0 * NPROJ + n0, NPROJ, Win_t + (size_t)n0 * D + k0, D, scr, F.lane); continue; } r -= I_IN;
            if (r < I_OUT) { const int nblk = D / 32, k0 = 64 * (r / nblk), n0 = 32 * (r % nblk);
                p0_transpose_tile(args.in[13] + (size_t)k0 * D + n0, D, Wout_t + (size_t)n0 * D + k0, D, scr, F.lane); continue; } r -= I_OUT;
            if (r < 2 * I_G) { const int up = r >= I_G; if (up) r -= I_G;
                const int e = r / 128, q = r % 128, k0 = 64 * (q / 8), n0 = 32 * (q % 8);
                const int drow = (n0 >> 7) * 256 + (up ? 128 : 0) + (n0 & 127);
                p0_transpose_tile(args.in[up ? 19 : 18] + (size_t)e * D * FF + (size_t)k0 * FF + n0, FF, Wgu_t + ((size_t)e * 512 + drow) * D + k0, D, scr, F.lane); continue; } r -= 2 * I_G;
            { const int e = r / 128, q = r % 128, k0 = 64 * (q / 32), n0 = 32 * (q % 32);
              p0_transpose_tile(args.in[20] + (size_t)e * FF * D + (size_t)k0 * D + n0, D, Wd_t + ((size_t)e * D + n0) * FF + k0, FF, scr, F.lane); }
        }
        __syncthreads();
        F.lane = lane_id_v(); F.tid = F.wave * 64 + F.lane;
        LAS float* cs = (LAS float*)(F.lds);
        LAS float* red = (LAS float*)(F.lds + 32768);
        _Pragma("unroll") for (int rm_ = 0; rm_ < REPS(12); ++rm_)
        for (int item = blockIdx.x; item < 192; item += F.G) {
            for (int i = F.tid; i < 8 * 1024; i += 512) { const float cv = args.in[1][i]; cs[i] = cv * sigmoidf_(cv); }
            __syncthreads();
            float a[8];
#pragma unroll
            for (int b = 0; b < 8; ++b) a[b] = 0.f;
            const int col = F.lane & 31, kb = 128 * F.wave + 64 * (F.lane >> 5);
            const float* wp = args.in[6] + (size_t)kb * 6144 + item * 32 + col;
#pragma unroll 1
            for (int k0 = 0; k0 < 64; k0 += 16) { float wv[16];
#pragma unroll
                for (int k = 0; k < 16; ++k) wv[k] = __builtin_nontemporal_load(&wp[(size_t)(k0 + k) * 6144]);
#pragma unroll
                for (int b = 0; b < 8; ++b)
#pragma unroll
                    for (int k4 = 0; k4 < 16; k4 += 4) { const f32x4 c4 = *(const LAS f32x4*)(cs + b * 1024 + kb + k0 + k4);
                        a[b] += c4[0] * wv[k4] + c4[1] * wv[k4 + 1] + c4[2] * wv[k4 + 2] + c4[3] * wv[k4 + 3]; } }
#pragma unroll
            for (int b = 0; b < 8; ++b) { a[b] += __shfl_xor(a[b], 32); if (F.lane < 32) red[(F.wave * 8 + b) * 32 + col] = a[b]; }
            __syncthreads();
            if (F.tid < 256) { const int b = F.tid >> 5, c = F.tid & 31; float s_ = args.in[7][item * 32 + c];
#pragma unroll
              for (int w = 0; w < 8; ++w) s_ += red[(w * 8 + b) * 32 + c];
              mod[b * 6144 + item * 32 + c] = s_; }
            __syncthreads();
        }
        for (int i = blockIdx.x * 512 + F.tid; i < 48 * 1024; i += F.G * 512) { const int n = i >> 10, k = i & 1023;
            const float wv = n < 4 ? args.in[14][k * 4 + n] : (n < 36 ? args.in[16][k * 32 + (n - 4)] : 0.f);
            const unsigned hi = f2bf(wv); const float lo = wv - bflo(hi);
            WrT[i] = (bf16)hi; WrT[48 * 1024 + i] = (bf16)f2bf(lo); }
        if (blockIdx.x == (unsigned)(F.G - 1)) { const int i = F.tid; const float a0 = args.in[11][i], a1 = args.in[11][512 + i]; lbv[i] = 1.0f / (1.0f + __expf(a1 - a0)); }
        if (BOTH(0)) GRID_BAR();
    }

    if (IN(1)) _Pragma("unroll") for (int rep_ = 0; rep_ < REPS(1); ++rep_) {
        F.lane = lane_id_v(); F.tid = F.wave * 64 + F.lane;
        const float* g1 = args.in[2];
        f32x4 vn[4];
        if (gw < M) { const GAS f32x4* xr = (const GAS f32x4*)(x + (size_t)gw * D) + F.lane;
#pragma unroll
            for (int j = 0; j < 4; ++j) vn[j] = __builtin_nontemporal_load(&xr[64 * j]); }
        for (int m = gw; m < M; m += NGW) {
            const int b = m / T;
            f32x4 v[4]; float s = 0.f;
#pragma unroll
            for (int j = 0; j < 4; ++j) { v[j] = vn[j]; s += (v[j].x * v[j].x + v[j].y * v[j].y) + (v[j].z * v[j].z + v[j].w * v[j].w); }
            if (m + NGW < M) { const GAS f32x4* xr = (const GAS f32x4*)(x + (size_t)(m + NGW) * D) + F.lane;
#pragma unroll
                for (int j = 0; j < 4; ++j) vn[j] = __builtin_nontemporal_load(&xr[64 * j]); }
            const float rstd = rsqrtf(wave_sum(s) * (1.f / D) + NORM_EPS);
            GAS v2u* o8 = (GAS v2u*)(Hb + (size_t)m * D) + F.lane;
#pragma unroll
            for (int j = 0; j < 4; ++j) { const int k = 4 * F.lane + 256 * j;
                const f32x4 g = *(const f32x4*)(g1 + k), sh = *(const f32x4*)(mod + b * 6144 + k), sc = *(const f32x4*)(mod + b * 6144 + 1024 + k);
                const f32x4 h = v[j] * rstd * g * (sc + 1.0f) + sh;
                v2u o; o.x = pk2(h.x, h.y); o.y = pk2(h.z, h.w); o8[64 * j] = o; }
        }
        if (BOTH(1)) GRID_BAR();
    }

    if (IN(2)) _Pragma("unroll") for (int rep_ = 0; rep_ < REPS(2); ++rep_) {
        F.lane = lane_id_v(); F.tid = F.wave * 64 + F.lane;
        pg8::PlainProb P{(const char*)Hb, (const char*)Win_t, D}; pg8::StaticOrder S; S.init(M, NPROJ, F.G, (int)blockIdx.x);
        pg8::EpiProj E{PROJ, T, PJ_KA, PJ_VA, PJ_XH, PJ_XSZ, F.lds + CS_OFF + F.wave * 2048};
        pg8::gemm_phase2<pg8::PlainProb, pg8::EpiProj, pg8::StaticOrder, true>(F.lds + RING_OFF, P, S, E, F.wave);
        if (BOTH(2)) GRID_BAR();
    }

    if (IN(3)) _Pragma("unroll") for (int rep_ = 0; rep_ < REPS(3); ++rep_) {
        F.lane = lane_id_v(); F.tid = F.wave * 64 + F.lane;
        static_assert(hg::LDS_NEED <= P3_LDS_END && hg::SP_NEED <= P3_LDS_END, "hgrn LDS");
        _Pragma("unroll") for (int rs_ = 0; rs_ < REPS(10); ++rs_)
        for (int un = blockIdx.x; un < 256; un += F.G) hg::unit_state(F.lds, F.tid, un, PROJ, lbv, Useg, Dseg);
        {
            LAS unsigned char* Ks = F.lds;
            LAS unsigned char* Vs = F.lds + 73728;
            LAS float* ssq = (LAS float*)(F.lds + 147456);
            static_assert(147456 + 4096 <= P3_LDS_END, "attention LDS");
            const float* sinks = args.in[9]; const float* anorm = args.in[10];
            const int h = F.wave, g = h >> 2, ql = F.lane & 31, hf = F.lane >> 5;
            const float LOG2E = 1.4426950408889634f;
            const float c1 = 0.125f * LOG2E, slope2 = exp2f(-(float)(h + 1)) * LOG2E, sink2 = sinks[h] * LOG2E;
            for (int item2 = blockIdx.x; item2 < REPS(11) * (M / 128); item2 += F.G) { const int item = item2 & (M / 128 - 1);
                const int b = item >> 6, nb = item & 63, t0 = nb * 128; const size_t row0 = (size_t)b * T + t0;
                __syncthreads();
                {
                    const unsigned kto = (unsigned)F.tid * 16u;
                    LAS unsigned char* kl = Ks + (F.tid >> 3) * 144 + 16 * (F.tid & 7); LAS unsigned char* vl = Vs + (F.tid >> 3) * 144 + 16 * (F.tid & 7);
#pragma unroll
                    for (int i = 0; i < 8; ++i) { const int gg = i >> 2, k64 = 64 * (i & 3);
                        const char* kb = (const char*)(PROJ + PJ_KA) + ((size_t)(b * 2 + gg) * T + t0 - 128 + k64) * 128;
                        const char* vb = (const char*)(PROJ + PJ_VA) + ((size_t)(b * 2 + gg) * T + t0 - 128 + k64) * 128;
                        v4u kv = (v4u){0u, 0u, 0u, 0u}, vv = kv;
                        if (nb > 0 || (i & 3) >= 2) { kv = *(const GAS v4u*)(kb + kto); vv = *(const GAS v4u*)(vb + kto); }
                        *(LAS v4u*)(kl + (gg * 256 + k64) * 144) = kv; *(LAS v4u*)(vl + (gg * 256 + k64) * 144) = vv; }
                }
                __syncthreads();
                bf16x8 qn[4];
                { const bf16* qp = PROJ + PJ_QA + ((size_t)(b * 8 + h) * T + t0 + ql) * 64 + 8 * hf;
#pragma unroll
                  for (int s4 = 0; s4 < 4; ++s4) qn[s4] = __builtin_nontemporal_load((const GAS bf16x8*)(qp + 16 * s4)); }
                for (int qt = 0; qt < 4; ++qt) {
                    bf16x8 qf[4];
#pragma unroll
                    for (int s4 = 0; s4 < 4; ++s4) qf[s4] = qn[s4];
                    if (qt < 3) { const bf16* qp = PROJ + PJ_QA + ((size_t)(b * 8 + h) * T + t0 + 32 * (qt + 1) + ql) * 64 + 8 * hf;
#pragma unroll
                      for (int s4 = 0; s4 < 4; ++s4) qn[s4] = __builtin_nontemporal_load((const GAS bf16x8*)(qp + 16 * s4)); }
                    f32x16 st[5];
#pragma unroll
                    for (int k5 = 0; k5 < 5; ++k5) { f32x16 a;
#pragma unroll
                        for (int r = 0; r < 16; ++r) a[r] = 0.f;
                        const LAS unsigned char* kp = Ks + (g * 256 + (qt + k5) * 32 + ql) * 144 + 16 * hf;
#pragma unroll
                        for (int s4 = 0; s4 < 4; ++s4) { const bf16x8 ka = *(const LAS bf16x8*)(kp + 32 * s4); a = __builtin_amdgcn_mfma_f32_32x32x16_bf16(ka, qf[s4], a, 0, 0, 0); }
                        st[k5] = a; }
                    float mx = sink2;
                    const float lb0 = -slope2 * (float)(ql + 128 - 4 * hf);
#pragma unroll
                    for (int k5 = 0; k5 < 5; ++k5) { const bool tile_ok = (nb > 0) || (qt + k5 >= 4); const float lbk = lb0 + slope2 * (float)(32 * k5);
#pragma unroll
                        for (int r = 0; r < 16; ++r) { const int c0 = (r & 3) + 8 * (r >> 2);
                            float v = st[k5][r] * c1 + (lbk + slope2 * (float)c0);
                            bool ok = tile_ok;
                            if (k5 == 0) ok = ok && (c0 + 4 * hf > ql);
                            if (k5 == 4) ok = ok && (c0 + 4 * hf <= ql);
                            v = ok ? v : -1.0e30f; st[k5][r] = v; mx = fmaxf(mx, v); } }
                    mx = fmaxf(mx, __shfl_xor(mx, 32));
                    float sum = 0.f;
#pragma unroll
                    for (int k5 = 0; k5 < 5; ++k5)
#pragma unroll
                        for (int r = 0; r < 16; ++r) { const float p = __builtin_amdgcn_exp2f(st[k5][r] - mx);   st[k5][r] = p; sum += p; }
                    sum += __shfl_xor(sum, 32); sum += __builtin_amdgcn_exp2f(sink2 - mx);
                    const float inv = 1.0f / sum;
                    f32x16 o0, o1;
#pragma unroll
                    for (int r = 0; r < 16; ++r) { o0[r] = 0.f; o1[r] = 0.f; }
#pragma unroll
                    for (int k5 = 0; k5 < 5; ++k5)
#pragma unroll
                        for (int s2 = 0; s2 < 2; ++s2) {
                            v4u pp; pp.x = cvtpk_s(st[k5][8 * s2 + 0], st[k5][8 * s2 + 1]); pp.y = cvtpk_s(st[k5][8 * s2 + 2], st[k5][8 * s2 + 3]);
                            pp.z = cvtpk_s(st[k5][8 * s2 + 4], st[k5][8 * s2 + 5]); pp.w = cvtpk_s(st[k5][8 * s2 + 6], st[k5][8 * s2 + 7]);
                            const bf16x8 pb = __builtin_bit_cast(bf16x8, pp);
                            const int kb = (qt + k5) * 32 + 16 * s2 + 4 * hf; const int i16 = F.lane & 15, dsel = (F.lane >> 4) & 1;
                            const LAS unsigned char* vp = Vs + (g * 256 + kb + (i16 >> 2)) * 144 + (16 * dsel + 4 * (i16 & 3)) * 2;
                            { const s16x4 lo = vtr16(vp), hi = vtr16(vp + 8 * 144);
                              const bf16x8 va = __builtin_shufflevector(lo, hi, 0, 1, 2, 3, 4, 5, 6, 7); o0 = __builtin_amdgcn_mfma_f32_32x32x16_bf16(va, pb, o0, 0, 0, 0); }
                            { const s16x4 lo = vtr16(vp + 64), hi = vtr16(vp + 64 + 8 * 144);
                              const bf16x8 va = __builtin_shufflevector(lo, hi, 0, 1, 2, 3, 4, 5, 6, 7); o1 = __builtin_amdgcn_mfma_f32_32x32x16_bf16(va, pb, o1, 0, 0, 0); }
                        }
                    float sq = 0.f;
                    bf16* op = MIXIN + (row0 + 32 * qt + ql) * D + h * 64 + 4 * hf;
#pragma unroll
                    for (int rg = 0; rg < 4; ++rg) {
                        const float a0 = o0[4 * rg] * inv, a1 = o0[4 * rg + 1] * inv, a2 = o0[4 * rg + 2] * inv, a3 = o0[4 * rg + 3] * inv;
                        const float b0 = o1[4 * rg] * inv, b1 = o1[4 * rg + 1] * inv, b2 = o1[4 * rg + 2] * inv, b3 = o1[4 * rg + 3] * inv;
                        sq += (a0 * a0 + a1 * a1) + (a2 * a2 + a3 * a3) + (b0 * b0 + b1 * b1) + (b2 * b2 + b3 * b3);
                        *(GAS v2u*)(op + 8 * rg) = (v2u){cvtpk_s(a0, a1), cvtpk_s(a2, a3)};
                        *(GAS v2u*)(op + 32 + 8 * rg) = (v2u){cvtpk_s(b0, b1), cvtpk_s(b2, b3)}; }
                    sq += __shfl_xor(sq, 32);
                    if (hf == 0) ssq[h * 128 + 32 * qt + ql] = sq;
                }
                __syncthreads();
                { const f32x4 n0 = *(const f32x4*)(anorm + 8 * F.lane), n1 = *(const f32x4*)(anorm + 8 * F.lane + 4);
#pragma unroll
                  for (int i0 = 0; i0 < 16; i0 += 8) {
                    v4u uu[8];
#pragma unroll
                    for (int i = 0; i < 8; ++i) uu[i] = *(const GAS v4u*)(MIXIN + (row0 + 16 * F.wave + i0 + i) * D + 8 * F.lane);
#pragma unroll
                    for (int i = 0; i < 8; ++i) { const int tt = 16 * F.wave + i0 + i;
                        float ss = 0.f;
#pragma unroll
                        for (int hh = 0; hh < 8; ++hh) ss += ssq[hh * 128 + tt];
                        const float rstd = rsqrtf(ss * (1.f / 512.f) + NORM_EPS);
                        const v4u u = uu[i];
                        v4u o; o.x = cvtpk_s(bflo(u.x) * rstd * n0.x, bfhi(u.x) * rstd * n0.y); o.y = cvtpk_s(bflo(u.y) * rstd * n0.z, bfhi(u.y) * rstd * n0.w);
                        o.z = cvtpk_s(bflo(u.z) * rstd * n1.x, bfhi(u.z) * rstd * n1.y); o.w = cvtpk_s(bflo(u.w) * rstd * n1.z, bfhi(u.w) * rstd * n1.w);
                        *(GAS v4u*)(MIXIN + (row0 + tt) * D + 8 * F.lane) = o; } } }
            }
        }
        if (BOTH(3)) GRID_BAR();
    }

    if (IN(4)) _Pragma("unroll") for (int rep_ = 0; rep_ < REPS(4); ++rep_) {
        F.lane = lane_id_v(); F.tid = F.wave * 64 + F.lane;
        for (int un = blockIdx.x; un < 256; un += F.G) hg::unit<true>(F.lds, F.tid, un, PROJ, lbv, Useg, Dseg, args.in[12], MIXIN);
#if defined(P4DUP) && P4DUP
        for (int un = blockIdx.x; un < 256; un += F.G) hg::unit<true, P4DUP>(F.lds, F.tid, un, PROJ, lbv, Useg, Dseg, args.in[12], Hb);
#endif
        if (BOTH(4)) GRID_BAR();
    }

    if (IN(5)) _Pragma("unroll") for (int rep_ = 0; rep_ < REPS(5); ++rep_) {
        F.lane = lane_id_v(); F.tid = F.wave * 64 + F.lane;
        pg8::PlainProb P{(const char*)MIXIN, (const char*)Wout_t, D}; pg8::StaticOrder S; S.init(M, D, F.G, (int)blockIdx.x);
        pg8::EpiBf16W E{MIX, D, F.lds + CS_OFF + F.wave * 2048};
        pg8::gemm_phase2<pg8::PlainProb, pg8::EpiBf16W, pg8::StaticOrder, true, false>(F.lds + RING_OFF, P, S, E, F.wave);
        if (BOTH(5)) GRID_BAR();
    }

    if (IN(6)) {
        F.lane = lane_id_v(); F.tid = F.wave * 64 + F.lane;
        const float* g1p = args.in[3]; const float* g2 = args.in[4]; const float* brg = args.in[15]; const float* bre = args.in[17];
        constexpr int APITCH = 2064;
        LAS unsigned char* Ahi = F.lds; LAS unsigned char* Alo = F.lds + 16 * APITCH;
        LAS float* part = (LAS float*)(F.lds + 2 * 16 * APITCH);
        LAS float* red = part + 8 * 16 * 48;
        const int r16 = F.lane & 15, q4 = F.lane >> 4;
        int my_m = -1, my_e1 = 0, my_e2 = 0, my_w1 = 0, my_w2 = 0, nstep = 0;
        const int ngrp = M / 16;
        bf16x8 rbh[4][3];
#pragma unroll
        for (int ks = 0; ks < 4; ++ks)
#pragma unroll
            for (int nt = 0; nt < 3; ++nt) { const bf16* wp = WrT + (size_t)(16 * nt + r16) * 1024 + 128 * F.wave + 32 * ks + 8 * q4;
                rbh[ks][nt] = *(const GAS bf16x8*)wp; }
        v2u mixn[2][4]; f32x4 xnx[2][4];
#define P6_FETCH(gg) do { _Pragma("unroll") for (int rr_ = 0; rr_ < 2; ++rr_) { const int m_ = (gg) * 16 + 2 * F.wave + rr_; \
            const GAS v2u* mr_ = (const GAS v2u*)(MIX + (size_t)m_ * D) + F.lane; const GAS f32x4* xr_ = (const GAS f32x4*)(x + (size_t)m_ * D) + F.lane; \
            _Pragma("unroll") for (int j = 0; j < 4; ++j) { mixn[rr_][j] = __builtin_nontemporal_load(&mr_[64 * j]); xnx[rr_][j] = __builtin_nontemporal_load(&xr_[64 * j]); } } } while (0)
        if ((int)blockIdx.x < ngrp) P6_FETCH((int)blockIdx.x);
        for (int grp = blockIdx.x; grp < ngrp; grp += F.G) {
            const int m0 = grp * 16; const int b = m0 / T; const float* mb = mod + b * 6144;
            {
                f32x4 v[2][4]; float s1[2] = {0.f, 0.f}, s2[2] = {0.f, 0.f};
#pragma unroll
                for (int rr = 0; rr < 2; ++rr)
#pragma unroll
                    for (int j = 0; j < 4; ++j) { const v2u u = mixn[rr][j]; v[rr][j] = (f32x4){bflo(u.x), bfhi(u.x), bflo(u.y), bfhi(u.y)};
                        s1[rr] += (v[rr][j].x * v[rr][j].x + v[rr][j].y * v[rr][j].y) + (v[rr][j].z * v[rr][j].z + v[rr][j].w * v[rr][j].w); }
#pragma unroll
                for (int o = 1; o < 64; o <<= 1) { const float t0 = __shfl_xor(s1[0], o), t1 = __shfl_xor(s1[1], o); s1[0] += t0; s1[1] += t1; }
                const float r1a = rsqrtf(s1[0] * (1.f / D) + NORM_EPS), r1b = rsqrtf(s1[1] * (1.f / D) + NORM_EPS);
#pragma unroll
                for (int j = 0; j < 4; ++j) { const int k = 4 * F.lane + 256 * j;
                    const f32x4 g = *(const f32x4*)(g1p + k), ga = *(const f32x4*)(mb + 2048 + k);
#pragma unroll
                    for (int rr = 0; rr < 2; ++rr) { v[rr][j] = xnx[rr][j] + ga * (v[rr][j] * (rr ? r1b : r1a) * g);
                        s2[rr] += (v[rr][j].x * v[rr][j].x + v[rr][j].y * v[rr][j].y) + (v[rr][j].z * v[rr][j].z + v[rr][j].w * v[rr][j].w); } }
#pragma unroll
                for (int o = 1; o < 64; o <<= 1) { const float t0 = __shfl_xor(s2[0], o), t1 = __shfl_xor(s2[1], o); s2[0] += t0; s2[1] += t1; }
                const float r2a = rsqrtf(s2[0] * (1.f / D) + NORM_EPS), r2b = rsqrtf(s2[1] * (1.f / D) + NORM_EPS);
#pragma unroll
                for (int rr = 0; rr < 2; ++rr) { const int lr = 2 * F.wave + rr, m = m0 + lr; const float rstd2 = rr ? r2b : r2a;
                    GAS v2u* x1o = (GAS v2u*)(X1 + (size_t)m * D) + F.lane;
                    GAS v2u* h2o = (GAS v2u*)(H2 + (size_t)m * D) + F.lane;
#pragma unroll
                    for (int j = 0; j < 4; ++j) { const int k = 4 * F.lane + 256 * j;
                        { v2u o; o.x = cvtpk_s(v[rr][j].x, v[rr][j].y); o.y = cvtpk_s(v[rr][j].z, v[rr][j].w); __builtin_nontemporal_store(o, &x1o[64 * j]); }
                        const f32x4 g = *(const f32x4*)(g2 + k), sh = *(const f32x4*)(mb + 3072 + k), sc = *(const f32x4*)(mb + 4096 + k);
                        const f32x4 hv = v[rr][j] * rstd2 * g * (sc + 1.0f) + sh;
                        v2u hh; hh.x = cvtpk_s(hv.x, hv.y); hh.y = cvtpk_s(hv.z, hv.w); h2o[64 * j] = hh;
                        const f32x4 lo = hv - (f32x4){bflo(hh.x), bfhi(hh.x), bflo(hh.y), bfhi(hh.y)};
                        v2u ll; ll.x = cvtpk_s(lo.x, lo.y); ll.y = cvtpk_s(lo.z, lo.w);
                        *(LAS v2u*)(Ahi + lr * APITCH + 2 * k) = hh; *(LAS v2u*)(Alo + lr * APITCH + 2 * k) = ll; } }
            }
            bf16x8 rbl[4][3];
#pragma unroll
            for (int ks = 0; ks < 4; ++ks)
#pragma unroll
                for (int nt = 0; nt < 3; ++nt) rbl[ks][nt] = *(const GAS bf16x8*)(WrT + 48 * 1024 + (size_t)(16 * nt + r16) * 1024 + 128 * F.wave + 32 * ks + 8 * q4);
            if (grp + F.G < ngrp) P6_FETCH(grp + F.G);
            __syncthreads();
            {
                f32x4 acc[3];
#pragma unroll
                for (int nt = 0; nt < 3; ++nt) acc[nt] = (f32x4){0.f, 0.f, 0.f, 0.f};
#pragma unroll
                for (int ks = 0; ks < 4; ++ks) { const int k0 = 128 * F.wave + 32 * ks + 8 * q4;
                    const bf16x8 ah = *(const LAS bf16x8*)(Ahi + r16 * APITCH + 2 * k0), al = *(const LAS bf16x8*)(Alo + r16 * APITCH + 2 * k0);
#pragma unroll
                    for (int nt = 0; nt < 3; ++nt) { const bf16x8 bh = rbh[ks][nt], bl = rbl[ks][nt];
                        acc[nt] = __builtin_amdgcn_mfma_f32_16x16x32_bf16(ah, bh, acc[nt], 0, 0, 0);
                        acc[nt] = __builtin_amdgcn_mfma_f32_16x16x32_bf16(al, bh, acc[nt], 0, 0, 0);
                        acc[nt] = __builtin_amdgcn_mfma_f32_16x16x32_bf16(ah, bl, acc[nt], 0, 0, 0); } }
#pragma unroll
                for (int nt = 0; nt < 3; ++nt)
#pragma unroll
                    for (int r = 0; r < 4; ++r) part[(F.wave * 16 + 4 * q4 + r) * 48 + 16 * nt + r16] = acc[nt][r];
            }
            __syncthreads();
            for (int i = F.tid; i < 16 * 48; i += 512) { float t = 0.f;
#pragma unroll
                for (int w8 = 0; w8 < 8; ++w8) t += part[w8 * 16 * 48 + i];
                red[i] = t; }
            __syncthreads();
            if (F.wave == 0) {
                if (F.lane < 16) {
                    const LAS float* rl = red + F.lane * 48;
                    float gl[4];
#pragma unroll
                    for (int i = 0; i < 4; ++i) gl[i] = rl[i] + brg[i];
                    int gi = 0; float gm = gl[0];
#pragma unroll
                    for (int i = 1; i < 4; ++i) if (gl[i] > gm) { gm = gl[i]; gi = i; }
                    float gs = 0.f;
#pragma unroll
                    for (int i = 0; i < 4; ++i) gs += __expf(gl[i] - gm);
                    const float gwt = 1.0f / gs;
                    float el[8];
#pragma unroll
                    for (int i = 0; i < 8; ++i) el[i] = rl[4 + gi * 8 + i] + bre[gi * 8 + i];
                    int i1 = 0; float m1 = el[0];
#pragma unroll
                    for (int i = 1; i < 8; ++i) if (el[i] > m1) { m1 = el[i]; i1 = i; }
                    int i2 = -1; float m2 = -3.0e38f;
#pragma unroll
                    for (int i = 0; i < 8; ++i) if (i != i1 && el[i] > m2) { m2 = el[i]; i2 = i; }
                    const float rq = __expf(m2 - m1), w1 = 1.0f / (1.0f + rq), w2 = rq * w1;
                    const int tgt = 16 * (nstep & 3) + F.lane;
                    red[16 * 48 + tgt * 5 + 0] = __builtin_bit_cast(float, m0 + F.lane); red[16 * 48 + tgt * 5 + 1] = __builtin_bit_cast(float, gi * 8 + i1); red[16 * 48 + tgt * 5 + 2] = __builtin_bit_cast(float, gi * 8 + i2);
                    red[16 * 48 + tgt * 5 + 3] = gwt * w1; red[16 * 48 + tgt * 5 + 4] = gwt * w2;
                }
                ++nstep;
                const bool lastgrp = (grp + F.G >= ngrp);
                if ((nstep & 3) == 0 || lastgrp) {
                    LDS_WAIT(); asm volatile("" ::: "memory");
                    const int nval = ((nstep & 3) == 0) ? 64 : 16 * (nstep & 3);
                    const bool valid = F.lane < nval;
                    const LAS float* pr = red + 16 * 48 + F.lane * 5;
                    my_m = valid ? __builtin_bit_cast(int, pr[0]) : -1; my_e1 = valid ? __builtin_bit_cast(int, pr[1]) : 0; my_e2 = valid ? __builtin_bit_cast(int, pr[2]) : 0;
                    my_w1 = __builtin_bit_cast(int, pr[3]); my_w2 = __builtin_bit_cast(int, pr[4]);
                    const unsigned long long lt = (1ull << F.lane) - 1ull;
                    int r1 = 0, r2 = 0, ncnt = 0;
                    for (int e = 0; e < NEXP; ++e) {
                        const unsigned long long m1b = __ballot(valid && my_e1 == e), m2b = __ballot(valid && my_e2 == e);
                        const int c1 = __popcll(m1b), c2 = __popcll(m2b);
                        if (my_e1 == e) r1 = __popcll(m1b & lt);
                        if (my_e2 == e) r2 = c1 + __popcll(m2b & lt);
                        if (F.lane == e) ncnt = c1 + c2;
                    }
                    int base = 0;
                    if (F.lane < NEXP && ncnt > 0) base = (int)__hip_atomic_fetch_add(ecnt + F.lane, (unsigned)ncnt, __ATOMIC_RELAXED, __HIP_MEMORY_SCOPE_AGENT);
                    const int b1 = __shfl(base, my_e1), b2 = __shfl(base, my_e2);
                    if (valid) { list2[(size_t)my_e1 * M + b1 + r1] = (v2i){my_m * 2, my_w1}; list2[(size_t)my_e2 * M + b2 + r2] = (v2i){my_m * 2 + 1, my_w2};
                        tokpos[(size_t)my_m * 2] = (v2i){(my_e1 << 20) | (b1 + r1), my_w1}; tokpos[(size_t)my_m * 2 + 1] = (v2i){(my_e2 << 20) | (b2 + r2), my_w2}; }
                    if ((nstep & 3) != 0) nstep = (nstep + 3) & ~3;
                }
            }
        }
#undef P6_FETCH
        if (BOTH(6)) GRID_BAR();
    }

    LAS int* pref = (LAS int*)(F.lds + TAB_OFF); LAS int* cntl = pref + 40; LAS int* utab = (LAS int*)(F.lds + TAB_OFF + 512);
    if (IN(7) || IN(8)) {
        __syncthreads();
        if (F.tid < NEXP) cntl[F.tid] = (int)__hip_atomic_load(ecnt + F.tid, RLX_AGENT);
        __syncthreads();
        if (F.tid == 0) { int p = 0; for (int e = 0; e < NEXP; ++e) { pref[e] = p; p += (cntl[e] + 255) >> 8; } pref[NEXP] = p; }
        __syncthreads();
    }
    if (IN(7)) _Pragma("unroll") for (int rep_ = 0; rep_ < REPS(7); ++rep_) {
        F.lane = lane_id_v(); F.tid = F.wave * 64 + F.lane;
        const int U7 = pref[NEXP] * 2, RM7 = FLOWSEAM ? U7 / F.G : (1 << 20);
        pg8::GroupOrder S{pref, cntl, 2, F.G, F.vcu, M, 0, 1 << 20, F.G, RM7, nullptr, 0, 0, 0};
        { pg8::Unit u; for (int j = 0; j < 8 && S.next(j, u); ++j) { if (F.tid < 256) utab[j * 256 + F.tid] = (F.tid < u.nvalid) ? (list2[(size_t)u.lb + F.tid].x >> 1) : 0; } }
        __syncthreads();
        pg8::GatherProb P{(const char*)H2, (const char*)Wgu_t, D, utab};
        pg8::EpiGateUp E{ACT, F.lds + CS_OFF + F.wave * 2048};
        pg8::gemm_phase2<pg8::GatherProb, pg8::EpiGateUp, pg8::GroupOrder, true, true>(F.lds + RING_OFF, P, S, E, F.wave);
        if (BOTH(7)) GRID_BAR();
    }

    if (IN(8)) _Pragma("unroll") for (int rep_ = 0; rep_ < REPS(8); ++rep_) {
        F.lane = lane_id_v(); F.tid = F.wave * 64 + F.lane;
        const int U7 = pref[NEXP] * 2, RM7 = FLOWSEAM ? U7 / F.G : (1 << 20), TC7 = FLOWSEAM ? U7 - RM7 * F.G : 0;
        unsigned* flow = (unsigned*)(F.ctl + CW_FLOW);
        if (FLOWSEAM && F.vcu < TC7) {
            pg8::GroupOrder S{pref, cntl, 2, F.G, F.vcu, M, RM7 * F.G, 1 << 20, F.G, 1, flow, 1, 0, 0};
            { pg8::Unit u; if (S.next(0, u)) { if (F.tid < 256) utab[F.tid] = (F.tid < u.nvalid) ? (list2[(size_t)u.lb + F.tid].x >> 1) : 0; } }
            __syncthreads();
            pg8::GatherProb P{(const char*)H2, (const char*)Wgu_t, D, utab};
            pg8::EpiGateUp E{ACT, F.lds + CS_OFF + F.wave * 2048};
            pg8::gemm_phase2<pg8::GatherProb, pg8::EpiGateUp, pg8::GroupOrder, true, true>(F.lds + RING_OFF, P, S, E, F.wave);
        }
        const int U8 = pref[NEXP] * 4, R8 = (U8 + F.G - 1) / F.G; const bool drop = TC7 > 0 && TC7 * 4 <= F.G;
        const int c2 = (F.vcu - TC7 + F.G) % F.G;
        pg8::GroupOrder S{pref, cntl, 4, F.G, c2, M, 0, drop ? (R8 > 3 ? R8 - 3 : 0) : (1 << 20), F.G - TC7, 1 << 20, flow, TC7 > 0 ? 2 : 0, 2, (RM7 * F.G) / 2};
        pg8::DownProb P{(const char*)ACT, (const char*)Wd_t, FF};
        pg8::EpiFp8 E{Y8, F.lds + CS_OFF + F.wave * 2048};
        pg8::gemm_phase2<pg8::DownProb, pg8::EpiFp8, pg8::GroupOrder, true, true>(F.lds + RING_OFF, P, S, E, F.wave);
        if (BOTH(8)) GRID_BAR();
    }

    if (IN(9)) _Pragma("unroll") for (int rep_ = 0; rep_ < REPS(9); ++rep_) {
        F.lane = lane_id_v(); F.tid = F.wave * 64 + F.lane;
        if (!IN(7) && !IN(8)) {
            __syncthreads();
            if (F.tid < NEXP) cntl[F.tid] = (int)__hip_atomic_load(ecnt + F.tid, RLX_AGENT);
            __syncthreads();
            if (F.tid == 0) { int p = 0; for (int e = 0; e < NEXP; ++e) { pref[e] = p; p += (cntl[e] + 255) >> 8; } pref[NEXP] = p; }
            __syncthreads();
        }
        const float* g4 = args.in[5];
        unsigned yn0[4], yn1[4]; v2u xn[4]; float wn0 = 0.f, wn1 = 0.f;
        v2i tp0 = (v2i){0, 0}, tp1 = tp0;
#define P9_TOK(mm) do { tp0 = tokpos[(size_t)(mm) * 2]; tp1 = tokpos[(size_t)(mm) * 2 + 1]; } while (0)
#define P9_FETCH(mm) do { const int wb0_ = tp0.y, wb1_ = tp1.y; \
            wn0 = __builtin_bit_cast(float, wb0_) * 0.0625f; wn1 = __builtin_bit_cast(float, wb1_) * 0.0625f; \
            const size_t r0_ = (size_t)pref[tp0.x >> 20] * 256 + (tp0.x & 0xfffff), r1_ = (size_t)pref[tp1.x >> 20] * 256 + (tp1.x & 0xfffff); \
            const GAS unsigned* y0_ = (const GAS unsigned*)(Y8 + r0_ * 1024) + F.lane; const GAS unsigned* y1_ = (const GAS unsigned*)(Y8 + r1_ * 1024) + F.lane; const GAS v2u* x_ = (const GAS v2u*)(X1 + (size_t)(mm) * D) + F.lane; \
            _Pragma("unroll") for (int j = 0; j < 4; ++j) { yn0[j] = __builtin_nontemporal_load(&y0_[64 * j]); yn1[j] = __builtin_nontemporal_load(&y1_[64 * j]); xn[j] = __builtin_nontemporal_load(&x_[64 * j]); } } while (0)
        if (gw < M) { P9_TOK(gw); P9_FETCH(gw); }
        if (gw + NGW < M) P9_TOK(gw + NGW);
        for (int m = gw; m < M; m += NGW) {
            const int b = m / T; const float* mb = mod + b * 6144 + 5120;
            unsigned ya[4], yb[4]; v2u xu4[4]; const float w0 = wn0, w1 = wn1;
#pragma unroll
            for (int j = 0; j < 4; ++j) { ya[j] = yn0[j]; yb[j] = yn1[j]; xu4[j] = xn[j]; }
            if (m + NGW < M) P9_FETCH(m + NGW);
            if (m + 2 * NGW < M) P9_TOK(m + 2 * NGW);
            f32x4 v[4]; float s = 0.f;
#pragma unroll
            for (int j = 0; j < 4; ++j) { const int a = (int)ya[j], c = (int)yb[j];
                v[j] = (f32x4){__builtin_amdgcn_cvt_f32_fp8(a, 0), __builtin_amdgcn_cvt_f32_fp8(a, 1), __builtin_amdgcn_cvt_f32_fp8(a, 2), __builtin_amdgcn_cvt_f32_fp8(a, 3)} * w0
                     + (f32x4){__builtin_amdgcn_cvt_f32_fp8(c, 0), __builtin_amdgcn_cvt_f32_fp8(c, 1), __builtin_amdgcn_cvt_f32_fp8(c, 2), __builtin_amdgcn_cvt_f32_fp8(c, 3)} * w1;
                s += (v[j].x * v[j].x + v[j].y * v[j].y) + (v[j].z * v[j].z + v[j].w * v[j].w); }
            const float rstd = rsqrtf(wave_sum(s) * (1.f / D) + NORM_EPS);
            GAS f32x4* orow = (GAS f32x4*)(args.out + (size_t)m * D) + F.lane;
#pragma unroll
            for (int j = 0; j < 4; ++j) { const int k = 4 * F.lane + 256 * j; const v2u xu = xu4[j];
                const f32x4 x1v = (f32x4){bflo(xu.x), bfhi(xu.x), bflo(xu.y), bfhi(xu.y)};
                const f32x4 g = *(const f32x4*)(g4 + k), ga = *(const f32x4*)(mb + k);
                __builtin_nontemporal_store(x1v + ga * (v[j] * rstd * g), &orow[64 * j]); }
        }
#undef P9_FETCH
#undef P9_TOK
    }
#undef IN
#undef BOTH
}

extern "C" void kernel_launch(void* const* d_in, const int* in_sizes, int n_in, void* d_out, int out_size, void* d_ws, size_t ws_size, hipStream_t stream) {
    static int grid = 0;
    if (grid == 0) {
        if (n_in != 21 || in_sizes[0] != M * D || out_size != M * D || ws_size < WS_END) { fprintf(stderr, "kernel_launch: unexpected shapes (n_in %d, in0 %d, out %d, ws %zu)\n", n_in, n_in > 0 ? in_sizes[0] : -1, out_size, ws_size); grid = -1; return; }
        int dev = 0, cus = 0, per_cu = 0;
        if (hipGetDevice(&dev) != hipSuccess || hipDeviceGetAttribute(&cus, hipDeviceAttributeMultiprocessorCount, dev) != hipSuccess) { grid = -1; return; }
        if (hipFuncSetAttribute((const void*)fwd, hipFuncAttributeMaxDynamicSharedMemorySize, LDS_BYTES) != hipSuccess) { fprintf(stderr, "kernel_launch: hipFuncSetAttribute failed\n"); grid = -1; return; }
        if (hipOccupancyMaxActiveBlocksPerMultiprocessor(&per_cu, (const void*)fwd, NWAVES * 64, LDS_BYTES) != hipSuccess || per_cu < 1)
            fprintf(stderr, "kernel_launch: occupancy query reports %d workgroups per CU\n", per_cu);
        (void)hipGetLastError();
        grid = cus;
    }
    if (grid < 0) return;
    if (hipMemsetAsync((char*)d_ws + WS_CTL, 0, CTL_ZERO_BYTES, stream) != hipSuccess) return;
    Args a{};
    for (int i = 0; i < 21; ++i) a.in[i] = (const float*)d_in[i];
    a.out = (float*)d_out; a.ws = (unsigned char*)d_ws;
    if (N_LAUNCHES == 1) { a.ph_lo = 0; a.ph_hi = N_PHASES; hipLaunchKernelGGL(fwd, dim3(grid), dim3(NWAVES * 64), LDS_BYTES, stream, a); }
    else for (int li = 0; li < N_PHASES; ++li) { a.ph_lo = li; a.ph_hi = li + 1; hipLaunchKernelGGL(fwd, dim3(grid), dim3(NWAVES * 64), LDS_BYTES, stream, a); }
}
```

```cpp
#include <hip/hip_runtime.h>
#include <cstdio>
#include <cstdint>
#ifndef EPI2
#define EPI2 0
#endif
#ifndef P4DUP
#define P4DUP 0
#endif
__device__ __forceinline__ int lane_id_v() { int l; asm volatile("v_mbcnt_lo_u32_b32 %0, -1, 0\n\tv_mbcnt_hi_u32_b32 %0, -1, %0" : "=v"(l)); return l; }
namespace pg8 {
#define PG8_LAS __attribute__((address_space(3)))
typedef unsigned short bf16_t;
typedef short bf16x8 __attribute__((ext_vector_type(8)));
typedef float f32x4 __attribute__((ext_vector_type(4)));
typedef unsigned u32x4 __attribute__((ext_vector_type(4)));
constexpr int BM = 256, BK = 64, HALF = 128, HTB = HALF * BK * 2  , STAGE_BYTES = 8 * HTB, NXCD = 8, WGM = 8;

__host__ __device__ __forceinline__ int lds_byte(int r, int c) { const int st = (r >> 4) * 2 + (c >> 5), rr = r & 15, cc = c & 31, ob = rr * 64 + cc * 2; return st * 1024 + (ob ^ (((ob >> 9) & 1) << 5)); }
__host__ __device__ __forceinline__ void stage_rc(int b, int& R, int& C) { const int st = b / 1024, sb = b % 1024, swz = sb ^ (((sb >> 9) & 1) << 5); R = (st >> 1) * 16 + swz / 64; C = (st & 1) * 32 + (swz % 64) / 2; }
__host__ __device__ __forceinline__ int perm32(int rho) { const int n = rho >> 4, i = rho & 15; return 8 * (i >> 2) + 4 * n + (i & 3); }

struct Unit { int pm, pn, e, nvalid, lb, j; };
struct Gemm { const bf16_t* A; const bf16_t* Bt; int M, N, K; };

struct StaticOrder {
    int nM, nN, nwg, G, c;
    __host__ __device__ void init(int M, int N, int G_, int c_) { nM = M / BM; nN = N / BM; nwg = nM * nN; G = G_; c = c_; }
    __host__ __device__ bool next(int i, Unit& u) const {
        const long L = (long)i * G + c; if (L >= nwg) return false;
        int wgid = (int)L; { const int q = nwg / NXCD, r = nwg % NXCD, xcd = wgid % NXCD, off = wgid / NXCD; wgid = (xcd < r ? xcd * (q + 1) : r * (q + 1) + (xcd - r) * q) + off; }
        const int nig = WGM * nN, gid = wgid / nig, fm = gid * WGM, gsz = (nM - fm) < WGM ? (nM - fm) : WGM;
        u.pm = fm + ((wgid % nig) % gsz); u.pn = (wgid % nig) / gsz; u.e = 0; u.nvalid = 256; u.lb = 0; u.j = i; return true;
    }
    static constexpr bool FLOW = false;
    __device__ __forceinline__ void wait_ready(const Unit&) const {}
    __device__ __forceinline__ void signal_done(int) const {}
};


__device__ __forceinline__ unsigned cvt_pk_bf16(float lo, float hi) { unsigned r; asm volatile("v_cvt_pk_bf16_f32 %0, %1, %2" : "=v"(r) : "v"(lo), "v"(hi)); return r; }
__device__ __forceinline__ float silu_f(float x) { return x * __builtin_amdgcn_rcpf(1.0f + __expf(-x)); }
struct PlainProb {
    const char* A; const char* Bt; int K;
    __device__ __forceinline__ void a_offs(const Unit& u, const int (&R)[2], const int (&C)[2], unsigned (&o)[2][2]) const {
#pragma unroll
        for (int h = 0; h < 2; ++h)
#pragma unroll
            for (int i = 0; i < 2; ++i) o[h][i] = (unsigned)((u.pm * BM + h * HALF + R[i]) * K + C[i]) * 2u; }
    __device__ __forceinline__ const char* b_ptr(const Unit& u) const { return Bt + (size_t)u.pn * BM * K * 2; }
};
struct GatherProb {
    const char* A; const char* Bt; int K; const PG8_LAS int* tok;
    __device__ __forceinline__ void a_offs(const Unit& u, const int (&R)[2], const int (&C)[2], unsigned (&o)[2][2]) const {
#pragma unroll
        for (int h = 0; h < 2; ++h)
#pragma unroll
            for (int i = 0; i < 2; ++i) o[h][i] = (unsigned)(tok[u.j * BM + h * HALF + R[i]] * K + C[i]) * 2u; }
    __device__ __forceinline__ const char* b_ptr(const Unit& u) const { return Bt + ((size_t)u.e * 512 + (size_t)u.pn * BM) * K * 2; }
};
struct DownProb {
    const char* A; const char* Bt; int K;
    __device__ __forceinline__ void a_offs(const Unit& u, const int (&R)[2], const int (&C)[2], unsigned (&o)[2][2]) const {
#pragma unroll
        for (int h = 0; h < 2; ++h)
#pragma unroll
            for (int i = 0; i < 2; ++i) o[h][i] = (unsigned)((u.pm * BM + h * HALF + R[i]) * K + C[i]) * 2u; }
    __device__ __forceinline__ const char* b_ptr(const Unit& u) const { return Bt + ((size_t)u.e * 1024 + (size_t)u.pn * BM) * K * 2; }
};
struct GroupOrder {
    const PG8_LAS int* pref; const PG8_LAS int* cnt; int npn, G, c, lbstride;
    int Lbase, icut, G2, imax;
    unsigned* flow; int mode  , need, rt0;
    static constexpr bool FLOW = true;
    __device__ __forceinline__ void wait_ready(const Unit& u) const {
        if (mode == 2 && u.pm >= rt0) { while (__hip_atomic_load(flow + u.pm, __ATOMIC_RELAXED, __HIP_MEMORY_SCOPE_AGENT) < (unsigned)need) __builtin_amdgcn_s_sleep(4);
            __builtin_amdgcn_fence(__ATOMIC_ACQUIRE, "agent"); }
    }
    __device__ __forceinline__ void signal_done(int pm) const {
        if (mode == 1) { __builtin_amdgcn_fence(__ATOMIC_RELEASE, "agent"); if (lane_id_v() == 0) __hip_atomic_fetch_add(flow + pm, 1u, __ATOMIC_RELAXED, __HIP_MEMORY_SCOPE_AGENT); }
    }
    __device__ __forceinline__ bool next(int i, Unit& u) const {
        if (i >= imax || (i >= icut && c >= G2)) return false;
        const int L = Lbase + (i < icut ? i * G : icut * G + (i - icut) * G2) + c; const int total = __builtin_amdgcn_readfirstlane(pref[32]) * npn; if (L >= total) return false;
        const int tix = L / npn; u.pn = L - tix * npn; u.pm = tix;
        int e = 0;
        for (int k = 1; k < 32; ++k) e += (tix >= pref[k]) ? 1 : 0;
        e = __builtin_amdgcn_readfirstlane(e);
        const int tile = tix - __builtin_amdgcn_readfirstlane(pref[e]); const int nv = __builtin_amdgcn_readfirstlane(cnt[e]) - tile * BM;
        u.e = e; u.nvalid = nv < BM ? nv : BM; u.lb = e * lbstride + tile * BM; u.j = i; return true;
    }
};
struct EpiBf16S {
    static constexpr bool PERM = true, PERM2 = false; static constexpr int MIN_STORES = 16;
    bf16_t* O; int ldc;
    __device__ __forceinline__ void operator()(const f32x4 (&acc)[2][2][4][2], const Unit& u, int wr, int wc, int fr, int fq) const {
        const int row0 = u.pm * BM + wr * 64 + fr; const int col0 = u.pn * BM + wc * 32 + 8 * fq;
#pragma unroll
        for (int ai = 0; ai < 2; ++ai)
#pragma unroll
            for (int m = 0; m < 4; ++m) { bf16_t* rowp = O + (size_t)(row0 + ai * HALF + m * 16) * ldc + col0;
#pragma unroll
                for (int bj = 0; bj < 2; ++bj) { const f32x4 v0 = acc[ai][bj][m][0], v1 = acc[ai][bj][m][1];
                    u32x4 w; w.x = cvt_pk_bf16(v0[0], v0[1]); w.y = cvt_pk_bf16(v0[2], v0[3]); w.z = cvt_pk_bf16(v1[0], v1[1]); w.w = cvt_pk_bf16(v1[2], v1[3]);
                    *(u32x4*)(rowp + bj * HALF) = w; } }
    }
};

__device__ __forceinline__ int cs_w128(int fr, int fq, int bj) { return fr * 128 + (((2 * fq + bj) ^ (fr & 7)) << 4); }
__device__ __forceinline__ int cs_r128(int lane) { return (lane >> 3) * 128 + (((lane & 7) ^ ((lane >> 3) & 7)) << 4); }
__device__ __forceinline__ int cs_w64(int fr, int fq) { return fr * 64 + ((fq ^ ((fr >> 1) & 3)) << 4); }
__device__ __forceinline__ int cs_r64(int lane) { return (lane >> 2) * 64 + (((lane & 3) ^ ((lane >> 3) & 3)) << 4); }
struct EpiProj {
    static constexpr bool PERM = true, PERM2 = true; static constexpr int MIN_STORES = 16;
    bf16_t* O; int T; size_t ka_off, va_off, xh_off, x_sz; PG8_LAS unsigned char* cs;
    __device__ __forceinline__ void operator()(const f32x4 (&acc)[2][2][4][2], const Unit& u, int wr, int wc, int fr, int fq) const {
        const int lane = lane_id_v(), rr = lane >> 3, rc = lane & 7;
        const int bb = (u.pm * BM) / T;
        const int t0 = u.pm * BM - bb * T + wr * 64 + rr;
        const int c = u.pn * BM + wc * 64;
        bf16_t* p; int pitch;
        if (c < 512) { pitch = 64; p = O + (size_t)(bb * 8 + (c >> 6)) * T * 64; }
        else if (c < 768) { pitch = 64; p = O + ((c >= 640) ? va_off : ka_off) + (size_t)(bb * 2 + (((c - 512) >> 6) & 1)) * T * 64; }
        else { const int cc = c - 768; pitch = 128; p = O + xh_off + (size_t)(cc >> 9) * x_sz + (size_t)(cc & 127) + (size_t)(bb * 4 + ((cc >> 7) & 3)) * T * 128; }
        p += (size_t)t0 * pitch + rc * 8;
        PG8_LAS unsigned char* w0p = cs + cs_w128(lane & 15, lane >> 4, 0); PG8_LAS unsigned char* w1p = cs + cs_w128(lane & 15, lane >> 4, 1); const PG8_LAS unsigned char* rp_ = cs + cs_r128(lane);
        u32x4 r0[3], r1[3];
#pragma unroll
        for (int st = 0; st < 10; ++st) {
            if (st < 8) { const int ai = st >> 2, m = st & 3;
#pragma unroll
                for (int bj = 0; bj < 2; ++bj) { const f32x4 v0 = acc[ai][bj][m][0], v1 = acc[ai][bj][m][1];
                    u32x4 w; w.x = cvt_pk_bf16(v0[0], v0[1]); w.y = cvt_pk_bf16(v0[2], v0[3]); w.z = cvt_pk_bf16(v1[0], v1[1]); w.w = cvt_pk_bf16(v1[2], v1[3]);
                    *(PG8_LAS u32x4*)(bj ? w1p : w0p) = w; }
                r0[st % 3] = *(const PG8_LAS u32x4*)rp_; r1[st % 3] = *(const PG8_LAS u32x4*)(rp_ + 1024); }
            if (st >= 2) { const int so = st - 2, ai = so >> 2, m = so & 3; bf16_t* rp = p + (size_t)((ai * HALF + m * 16) * pitch);
                *(u32x4*)rp = r0[so % 3]; *(u32x4*)(rp + (size_t)(8 * pitch)) = r1[so % 3]; }
        }
    }
};

struct EpiFp8 {
    static constexpr bool PERM = true, PERM2 = true; static constexpr int MIN_STORES = 8;
    unsigned char* O; PG8_LAS unsigned char* cs;
    __device__ __forceinline__ void operator()(const f32x4 (&acc)[2][2][4][2], const Unit& u, int wr, int wc, int fr, int fq) const {
        const int lane = lane_id_v(), rr = lane >> 2, rc = lane & 3;
        unsigned char* p = O + (size_t)(u.pm * BM + wr * 64 + rr) * 1024 + u.pn * BM + wc * 64 + rc * 16;
        PG8_LAS unsigned char* wp = cs + cs_w64(lane & 15, lane >> 4); const PG8_LAS unsigned char* rp_ = cs + cs_r64(lane);
        u32x4 rb[3];
#pragma unroll
        for (int st = 0; st < 10; ++st) {
            if (st < 8) { const int ai = st >> 2, m = st & 3; int w[4];
#pragma unroll
                for (int bj = 0; bj < 2; ++bj) { const f32x4 v0 = acc[ai][bj][m][0] * 16.0f, v1 = acc[ai][bj][m][1] * 16.0f;
                    int w0 = 0, w1 = 0;
                    w0 = __builtin_amdgcn_cvt_pk_fp8_f32(v0[0], v0[1], w0, false); w0 = __builtin_amdgcn_cvt_pk_fp8_f32(v0[2], v0[3], w0, true);
                    w1 = __builtin_amdgcn_cvt_pk_fp8_f32(v1[0], v1[1], w1, false); w1 = __builtin_amdgcn_cvt_pk_fp8_f32(v1[2], v1[3], w1, true);
                    w[2 * bj] = w0; w[2 * bj + 1] = w1; }
                const u32x4 wv = {(unsigned)w[0], (unsigned)w[1], (unsigned)w[2], (unsigned)w[3]};
                *(PG8_LAS u32x4*)wp = wv;
                rb[st % 3] = *(const PG8_LAS u32x4*)rp_; }
            if (st >= 2) { const int so = st - 2, ai = so >> 2, m = so & 3; *(u32x4*)(p + (size_t)(ai * HALF + m * 16) * 1024) = rb[so % 3]; }
        }
    }
};

struct EpiBf16W {
    static constexpr bool PERM = true, PERM2 = true; static constexpr int MIN_STORES = 16;
    bf16_t* O; int ldc; PG8_LAS unsigned char* cs;
    __device__ __forceinline__ void operator()(const f32x4 (&acc)[2][2][4][2], const Unit& u, int wr, int wc, int fr, int fq) const {
        const int lane = lane_id_v(), rr = lane >> 3, rc = lane & 7;
        bf16_t* p = O + (size_t)(u.pm * BM + wr * 64 + rr) * ldc + u.pn * BM + wc * 64 + rc * 8;
        PG8_LAS unsigned char* w0p = cs + cs_w128(lane & 15, lane >> 4, 0); PG8_LAS unsigned char* w1p = cs + cs_w128(lane & 15, lane >> 4, 1); const PG8_LAS unsigned char* rp_ = cs + cs_r128(lane);
        u32x4 r0[3], r1[3];
#pragma unroll
        for (int st = 0; st < 10; ++st) {
            if (st < 8) { const int ai = st >> 2, m = st & 3;
#pragma unroll
                for (int bj = 0; bj < 2; ++bj) { const f32x4 v0 = acc[ai][bj][m][0], v1 = acc[ai][bj][m][1];
                    u32x4 w; w.x = cvt_pk_bf16(v0[0], v0[1]); w.y = cvt_pk_bf16(v0[2], v0[3]); w.z = cvt_pk_bf16(v1[0], v1[1]); w.w = cvt_pk_bf16(v1[2], v1[3]);
                    *(PG8_LAS u32x4*)(bj ? w1p : w0p) = w; }
                r0[st % 3] = *(const PG8_LAS u32x4*)rp_; r1[st % 3] = *(const PG8_LAS u32x4*)(rp_ + 1024); }
            if (st >= 2) { const int so = st - 2, ai = so >> 2, m = so & 3; bf16_t* rowp = p + (size_t)(ai * HALF + m * 16) * ldc;
                *(u32x4*)rowp = r0[so % 3]; *(u32x4*)(rowp + (size_t)8 * ldc) = r1[so % 3]; }
        }
    }
};
struct EpiGateUp {
    static constexpr bool PERM = true, PERM2 = false; static constexpr int MIN_STORES = 8;
    bf16_t* ACT; PG8_LAS unsigned char* cs;
    __device__ __forceinline__ void operator()(const f32x4 (&acc)[2][2][4][2], const Unit& u, int wr, int wc, int fr, int fq) const {
        const int lane = lane_id_v(), rr = lane >> 2, rc = lane & 3;
        bf16_t* p = ACT + (size_t)(u.pm * BM + wr * 64 + rr) * 256 + u.pn * HALF + wc * 32 + rc * 8;
        PG8_LAS unsigned char* wp = cs + cs_w64(lane & 15, lane >> 4); const PG8_LAS unsigned char* rp_ = cs + cs_r64(lane);
        u32x4 rb[3];
#pragma unroll
        for (int st = 0; st < 10; ++st) {
            if (st < 8) { const int ai = st >> 2, m = st & 3;
                const f32x4 g0 = acc[ai][0][m][0], g1 = acc[ai][0][m][1], u0 = acc[ai][1][m][0], u1 = acc[ai][1][m][1];
                u32x4 w; w.x = cvt_pk_bf16(silu_f(g0[0]) * u0[0], silu_f(g0[1]) * u0[1]); w.y = cvt_pk_bf16(silu_f(g0[2]) * u0[2], silu_f(g0[3]) * u0[3]);
                w.z = cvt_pk_bf16(silu_f(g1[0]) * u1[0], silu_f(g1[1]) * u1[1]); w.w = cvt_pk_bf16(silu_f(g1[2]) * u1[2], silu_f(g1[3]) * u1[3]);
                *(PG8_LAS u32x4*)wp = w;
                rb[st % 3] = *(const PG8_LAS u32x4*)rp_; }
            if (st >= 2) { const int so = st - 2, ai = so >> 2, m = so & 3; *(u32x4*)(p + (size_t)(ai * HALF + m * 16) * 256) = rb[so % 3]; }
        }
    }
};
struct EpiDown {
    static constexpr bool PERM = true, PERM2 = false; static constexpr int MIN_STORES = 0;
    bf16_t* Y; const PG8_LAS int* ent;
    __device__ __forceinline__ void operator()(const f32x4 (&acc)[2][2][4][2], const Unit& u, int wr, int wc, int fr, int fq) const {
        const int col0 = u.pn * BM + wc * 32 + 8 * fq;
#pragma unroll
        for (int ai = 0; ai < 2; ++ai)
#pragma unroll
            for (int m = 0; m < 4; ++m) { const int r = ai * HALF + wr * 64 + m * 16 + fr;
                const int dest = ent[(u.j * BM + r) * 2]; const float wt = __builtin_bit_cast(float, ent[(u.j * BM + r) * 2 + 1]);
                if (r < u.nvalid) { bf16_t* rowp = Y + (size_t)dest * 1024 + col0;
#pragma unroll
                    for (int bj = 0; bj < 2; ++bj) { const f32x4 v0 = acc[ai][bj][m][0] * wt, v1 = acc[ai][bj][m][1] * wt;
                        u32x4 w; w.x = cvt_pk_bf16(v0[0], v0[1]); w.y = cvt_pk_bf16(v0[2], v0[3]); w.z = cvt_pk_bf16(v1[0], v1[1]); w.w = cvt_pk_bf16(v1[2], v1[3]);
                        *(u32x4*)(rowp + bj * HALF) = w; } } }
    }
};
template <class Prob, class Epi, class Sched, bool ALIGN_EPI = false, bool POSTEPI = false>
__device__ __forceinline__ void gemm_phase2(PG8_LAS unsigned char* lds, const Prob& P, const Sched& S, const Epi& E, int wid  ) {
    constexpr bool SP2 = true;
    const int lane = lane_id_v(), tid = wid * 64 + lane, wr = wid >> 2, wc = wid & 3, fr = lane & 15, fq = lane >> 4;
    const int K = P.K, nt = K / BK;
    unsigned voffB[2];
#pragma unroll
    for (int i = 0; i < 2; ++i) { int R, C; stage_rc(tid * 16 + i * 8192, R, C);
        int Rb = Epi::PERM ? ((R & ~31) + perm32(R & 31)) : R;
        if (Epi::PERM2) Rb = (R >> 5) * 64 + ((R >> 2) & 3) * 16 + ((R >> 4) & 1) * 4 + (R & 3);
        voffB[i] = (unsigned)(Rb * K + C) * 2u; }
    const unsigned hstepB = Epi::PERM2 ? 8u * K * 2 : (unsigned)HALF * K * 2;
#define PG8_AOFFS(unit, dst) do { int RA_[2], CA_[2]; _Pragma("unroll") for (int i_ = 0; i_ < 2; ++i_) stage_rc(tid * 16 + i_ * 8192, RA_[i_], CA_[i_]); P.a_offs(unit, RA_, CA_, dst); } while (0)
    const unsigned kstep = BK * 2;
    const unsigned ldsw = (unsigned)wid * 1024u;
    const int aoff = lds_byte(wr * 64 + fr, fq * 8), boff = lds_byte(wc * 32 + fr, fq * 8);
#define PG8_SA(b, h) (((b) * 2 + (h)) * HTB)
#define PG8_SB(b, h) ((4 + (b) * 2 + (h)) * HTB)
#define PG8_STAGE(bufoff, RS, soff, voff) do { _Pragma("unroll") for (int _i = 0; _i < 2; ++_i) \
        __builtin_amdgcn_raw_ptr_buffer_load_lds(RS, (PG8_LAS void*)(lds + (bufoff) + ldsw + _i * 8192), 16, (int)(voff)[_i], (int)(soff), 0, 0); } while (0)
#define PG8_STAGE_SEL(bufoff, RS, soff, sel, vA, vB) do { _Pragma("unroll") for (int _i = 0; _i < 2; ++_i) \
        __builtin_amdgcn_raw_ptr_buffer_load_lds(RS, (PG8_LAS void*)(lds + (bufoff) + ldsw + _i * 8192), 16, (int)((sel) ? (vA)[_i] : (vB)[_i]), (int)(soff), 0, 0); } while (0)
#define PG8_LDA(dst, b, h) do { _Pragma("unroll") for (int m = 0; m < 4; ++m) _Pragma("unroll") for (int k = 0; k < 2; ++k) dst[m][k] = *(const PG8_LAS bf16x8*)(lds + PG8_SA(b, h) + aoff + m * 2048 + k * 1024); } while (0)
#define PG8_LDB(dst, b, h) do { _Pragma("unroll") for (int n = 0; n < 2; ++n) _Pragma("unroll") for (int k = 0; k < 2; ++k) dst[n][k] = *(const PG8_LAS bf16x8*)(lds + PG8_SB(b, h) + boff + n * 2048 + k * 1024); } while (0)
#define PG8_MMA(ai, bj, At, Bt) do { __builtin_amdgcn_s_setprio(1); _Pragma("unroll") for (int m = 0; m < 4; ++m) _Pragma("unroll") for (int n = 0; n < 2; ++n) _Pragma("unroll") for (int k = 0; k < 2; ++k) \
        acc[ai][bj][m][n] = __builtin_amdgcn_mfma_f32_16x16x32_bf16(Bt[n][k], At[m][k], acc[ai][bj][m][n], 0, 0, 0); __builtin_amdgcn_s_setprio(0); } while (0)
#define PG8_WAIT_V(n) asm volatile("s_waitcnt vmcnt(" #n ")" ::: "memory")
#define PG8_WAIT_VS(pe) do { if constexpr ((pe) && Epi::MIN_STORES >= 16) PG8_WAIT_V(24); else if constexpr ((pe) && Epi::MIN_STORES >= 8) PG8_WAIT_V(16); else PG8_WAIT_V(8); } while (0)
#define PG8_WAIT_L(n) asm volatile("s_waitcnt lgkmcnt(" #n ")" ::: "memory")
#define PG8_BAR __builtin_amdgcn_s_barrier()
#define PG8_SCHED __builtin_amdgcn_sched_barrier(0)
#define PG8_KITER(TT, PE) do { const int t = (TT); \
            const bool last = (t == nt - 2); \
            const unsigned a1 = (unsigned)(t + 1) * kstep; \
            const unsigned a2 = last ? 0u : (unsigned)(t + 2) * kstep; const unsigned b2 = last ? nB : cB + (unsigned)(t + 2) * kstep; \
            const unsigned a3 = a2 + kstep, b3 = b2 + kstep; \
            { \
            constexpr bool pe = (PE); \
            PG8_LDB(B0, 0, 0); PG8_LDB(B1, 0, 1); PG8_SCHED; PG8_LDA(At, 0, 0); if constexpr (!pe) PG8_STAGE(PG8_SA(1, 1), rA, a1, aoc[1]); \
            PG8_WAIT_VS(pe); PG8_WAIT_L(0); PG8_BAR; PG8_MMA(0, 0, At, B0); PG8_MMA(0, 1, At, B1); PG8_BAR; PG8_SCHED; \
            PG8_LDA(At, 0, 1); PG8_STAGE(PG8_SB(0, 0), rB, b2, voffB); PG8_STAGE(PG8_SB(0, 1), rB, b2 + hstepB, voffB); PG8_STAGE_SEL(PG8_SA(0, 0), rA, a2, last, aon[0], aoc[0]); \
            PG8_WAIT_VS(pe); PG8_WAIT_L(0); PG8_BAR; PG8_MMA(1, 0, At, B0); PG8_MMA(1, 1, At, B1); PG8_BAR; PG8_SCHED; \
            PG8_LDB(B0, 1, 0); PG8_LDB(B1, 1, 1); PG8_SCHED; PG8_LDA(At, 1, 0); PG8_STAGE_SEL(PG8_SA(0, 1), rA, a2, last, aon[1], aoc[1]); \
            PG8_WAIT_VS(pe); PG8_WAIT_L(0); PG8_BAR; PG8_MMA(0, 0, At, B0); PG8_MMA(0, 1, At, B1); PG8_BAR; PG8_SCHED; \
            PG8_LDA(At, 1, 1); PG8_STAGE(PG8_SB(1, 0), rB, b3, voffB); PG8_STAGE(PG8_SB(1, 1), rB, b3 + hstepB, voffB); PG8_STAGE_SEL(PG8_SA(1, 0), rA, a3, last, aon[0], aoc[0]); \
            PG8_WAIT_V(8); PG8_WAIT_L(0); PG8_BAR; PG8_MMA(1, 0, At, B0); PG8_MMA(1, 1, At, B1); PG8_BAR; PG8_SCHED; \
            } \
        } while (0)
    Unit cur, nxt; int ui = 0;
    if (!S.next(0, cur)) return;
    if constexpr (Sched::FLOW) S.wait_ready(cur);
    int prev_pm = -1;
    f32x4 acc[2][2][4][2];
#pragma unroll
    for (int a = 0; a < 2; ++a)
#pragma unroll
        for (int b = 0; b < 2; ++b)
#pragma unroll
            for (int m = 0; m < 4; ++m)
#pragma unroll
                for (int n = 0; n < 2; ++n) acc[a][b][m][n] = (f32x4){0.f, 0.f, 0.f, 0.f};
    bf16x8 At[4][2], B0[2][2], B1[2][2];
    const __amdgpu_buffer_rsrc_t rA = __builtin_amdgcn_make_buffer_rsrc((void*)P.A, (short)0, 0x7fffffff, 0x00020000);
    const __amdgpu_buffer_rsrc_t rB = __builtin_amdgcn_make_buffer_rsrc((void*)P.Bt, (short)0, 0x7fffffff, 0x00020000);
    unsigned cB = (unsigned)(P.b_ptr(cur) - P.Bt);
    unsigned aoc[2][2], aon[2][2]; PG8_AOFFS(cur, aoc);
    if constexpr (SP2) {
        PG8_STAGE(PG8_SB(0, 0), rB, cB, voffB); PG8_STAGE(PG8_SB(0, 1), rB, cB + hstepB, voffB); PG8_STAGE(PG8_SA(0, 0), rA, 0u, aoc[0]); PG8_STAGE(PG8_SA(0, 1), rA, 0u, aoc[1]);
        if (wr == 1) PG8_BAR;
        PG8_WAIT_V(2); PG8_BAR;
        PG8_STAGE(PG8_SB(1, 0), rB, cB + kstep, voffB); PG8_STAGE(PG8_SA(1, 0), rA, kstep, aoc[0]); PG8_STAGE(PG8_SB(1, 1), rB, cB + hstepB + kstep, voffB);
        PG8_WAIT_V(6); PG8_BAR;
    }
    for (;;) {
        const bool has_next = S.next(ui + 1, nxt);
        if constexpr (Sched::FLOW) { if (has_next) S.wait_ready(nxt); }
        const unsigned nB = has_next ? (unsigned)(P.b_ptr(nxt) - P.Bt) : cB;
        if (has_next) PG8_AOFFS(nxt, aon); else { aon[0][0] = aoc[0][0]; aon[0][1] = aoc[0][1]; aon[1][0] = aoc[1][0]; aon[1][1] = aoc[1][1]; }
        if constexpr (POSTEPI) { int t0_ = 0; if (ui > 0) { PG8_KITER(0, true); t0_ = 2; }
          for (int tt_ = t0_; tt_ < nt; tt_ += 2) PG8_KITER(tt_, false); }
        else { for (int tt_ = 0; tt_ < nt; tt_ += 2) PG8_KITER(tt_, false); }
        if constexpr (Sched::FLOW) { if (prev_pm >= 0 && wid == 0) S.signal_done(prev_pm); prev_pm = cur.pm; }
        if constexpr (POSTEPI) PG8_STAGE(PG8_SA(1, 1), rA, kstep, aon[1]);
        if constexpr (ALIGN_EPI) { if (wr == 0) PG8_BAR; }
        E(acc, cur, wr, wc, fr, fq);
#if defined(EPI2) && EPI2
        asm volatile("" ::: "memory"); E(acc, cur, wr, wc, fr, fq);
#endif
        if (!has_next) break;
#pragma unroll
        for (int a = 0; a < 2; ++a)
#pragma unroll
            for (int b = 0; b < 2; ++b)
#pragma unroll
                for (int m = 0; m < 4; ++m)
#pragma unroll
                    for (int n = 0; n < 2; ++n) acc[a][b][m][n] = (f32x4){0.f, 0.f, 0.f, 0.f};
        cur = nxt; cB = nB; ++ui;
        aoc[0][0] = aon[0][0]; aoc[0][1] = aon[0][1]; aoc[1][0] = aon[1][0]; aoc[1][1] = aon[1][1];
        if constexpr (ALIGN_EPI) { if (wr == 1) PG8_BAR; }
    }
    PG8_WAIT_V(0);
    if constexpr (!ALIGN_EPI) { if (wr == 0) PG8_BAR; }
    PG8_BAR;
    if constexpr (Sched::FLOW) { if (wid == 0) S.signal_done(prev_pm); }
#undef PG8_SA
#undef PG8_SB
#undef PG8_STAGE
#undef PG8_STAGE_SEL
#undef PG8_LDA
#undef PG8_LDB
#undef PG8_MMA
#undef PG8_WAIT_V
#undef PG8_WAIT_VS
#undef PG8_AOFFS
#undef PG8_KITER
#undef PG8_WAIT_L
#undef PG8_BAR
#undef PG8_SCHED
}
}
constexpr int NWAVES = 8;
#ifndef MK_N_LAUNCHES
#define MK_N_LAUNCHES 1
#endif
constexpr int N_PHASES = 10;
constexpr int N_LAUNCHES = MK_N_LAUNCHES;
constexpr int BATCH = 8, T = 8192, D = 1024, M = BATCH * T;
constexpr int NPROJ = 2816;
constexpr int OFF_QA = 0, OFF_KA = 512, OFF_VA = 640, OFF_QH = 768, OFF_FH = 1280, OFF_IH = 1792, OFF_GH = 2304;
constexpr int NEXP = 32, FF = 256;
constexpr size_t PJ_QA = 0, PJ_KA = (size_t)M * 512, PJ_VA = (size_t)M * 640, PJ_XH = (size_t)M * 768, PJ_XSZ = (size_t)M * 512;
constexpr float NORM_EPS = 1e-6f;

constexpr size_t MiB = 1u << 20;
constexpr size_t WS_CTL = 0, CTL_ZERO_BYTES = 64 * 1024;
constexpr size_t WS_MOD = 1 * MiB;
constexpr size_t WS_LB = 1 * MiB + 256 * 1024;
constexpr size_t WS_WRT = 2 * MiB;
constexpr size_t WS_TOKPOS = 3 * MiB;
constexpr size_t WS_WIN = 4 * MiB;
constexpr size_t WS_WOUT = 10 * MiB;
constexpr size_t WS_WGU = 12 * MiB;
constexpr size_t WS_WD = 44 * MiB;
constexpr size_t WS_VT = 76 * MiB;
constexpr size_t WS_LIST = 60 * MiB;
constexpr size_t WS_H = 96 * MiB;
constexpr size_t WS_PROJ = 224 * MiB;
constexpr size_t WS_MIXIN = 576 * MiB;
constexpr size_t WS_X1 = 704 * MiB;
constexpr size_t WS_ACT = 832 * MiB;
constexpr size_t WS_Y = WS_PROJ;
constexpr size_t WS_U = 904 * MiB;
constexpr size_t WS_DSEG = 920 * MiB;
constexpr size_t WS_END = 921 * MiB;

constexpr int CW_BAR = 4096;
constexpr int CW_CNT = 8192;
constexpr int CW_FLOW = 8320;
#ifndef FLOWSEAM
#define FLOWSEAM 1
#endif

constexpr int RING_OFF = 0, RING_BYTES = 131072;
constexpr int LDS_BYTES = 163840;
constexpr int LDSCTL_OFF = LDS_BYTES - 1024, MISC_OFF = LDSCTL_OFF + 320;
constexpr int TAB_OFF = RING_BYTES;
constexpr int CS_OFF = TAB_OFF + 8704;
static_assert(CS_OFF + 8 * 2048 <= LDSCTL_OFF, "epilogue staging");
constexpr int P3_LDS_END = LDSCTL_OFF;

#define GAS __attribute__((address_space(1)))
#define LAS __attribute__((address_space(3)))
typedef unsigned short bf16;
typedef unsigned v4u __attribute__((ext_vector_type(4)));
typedef unsigned v2u __attribute__((ext_vector_type(2)));
typedef float f32x4 __attribute__((ext_vector_type(4)));
typedef int v2i __attribute__((ext_vector_type(2)));
typedef short bf16x8 __attribute__((ext_vector_type(8)));
typedef short s16x4 __attribute__((ext_vector_type(4)));
typedef float f32x16 __attribute__((ext_vector_type(16)));
typedef float f32x2_t __attribute__((ext_vector_type(2)));
typedef __bf16 bf16x2_t __attribute__((ext_vector_type(2)));
__device__ __forceinline__ unsigned cvtpk_s(float lo, float hi) { f32x2_t v = {lo, hi}; bf16x2_t b = __builtin_convertvector(v, bf16x2_t); return __builtin_bit_cast(unsigned, b); }
__device__ __forceinline__ int crow32(int r, int hf) { return (r & 3) + 8 * (r >> 2) + 4 * hf; }
typedef short v4i16_t __attribute__((ext_vector_type(4)));
__device__ __forceinline__ s16x4 vtr16(const LAS unsigned char* p) { return __builtin_bit_cast(s16x4, __builtin_amdgcn_ds_read_tr16_b64_v4i16((LAS v4i16_t*)p)); }
typedef GAS unsigned gu32;
#define RLX_AGENT __ATOMIC_RELAXED, __HIP_MEMORY_SCOPE_AGENT
#define LDS_WAIT() asm volatile("s_waitcnt lgkmcnt(0)" ::: "memory")
__device__ __forceinline__ unsigned f2bf(float f) { unsigned u = __builtin_bit_cast(unsigned, f); return (u + 0x7fffu + ((u >> 16) & 1u)) >> 16; }
__device__ __forceinline__ unsigned pk2(float lo, float hi) { return f2bf(lo) | (f2bf(hi) << 16); }
__device__ __forceinline__ float bf2f(bf16 v) { return __builtin_bit_cast(float, (unsigned)v << 16); }
__device__ __forceinline__ float bflo(unsigned u) { return __builtin_bit_cast(float, u << 16); }
__device__ __forceinline__ float bfhi(unsigned u) { return __builtin_bit_cast(float, u & 0xffff0000u); }
__device__ __forceinline__ float sigmoidf_(float x) { return 1.0f / (1.0f + __expf(-x)); }

#define XB_TMO      128
#define XB_XCNT(j)  (256  + 64 * (j))
#define XB_XSUB(j)  (1280 + 64 * (j))
#define XB_XGEN(j)  (2304 + 64 * (j))
#define XB_TOP      3328
#define XB_TOPGEN   3392
#define XCD_BAR_WORDS 3456
#define XB_SPIN_CAP (1u << 18)

__device__ __forceinline__ unsigned xb_ld(unsigned* p)              { return __hip_atomic_load(p, __ATOMIC_RELAXED, __HIP_MEMORY_SCOPE_AGENT); }
__device__ __forceinline__ unsigned xb_add(unsigned* p, unsigned v) { return __hip_atomic_fetch_add(p, v, __ATOMIC_RELAXED, __HIP_MEMORY_SCOPE_AGENT); }
__device__ __forceinline__ unsigned xb_xcc_id() { return (unsigned)__builtin_amdgcn_s_getreg((3 << 11) | 20) & 0xFu; }
#define XB_SPIN(cond, bar) do { unsigned _sp = 0; while (cond) { __builtin_amdgcn_s_sleep(1); \
    if ((++_sp & 255u) == 0u) { if (xb_ld(&(bar)[XB_TMO])) break; if (_sp > XB_SPIN_CAP) { atomicAdd(&(bar)[XB_TMO], 1u); break; } } } } while (0)

struct XcdBarrier {
    unsigned* bar; unsigned x;
    volatile LAS unsigned* st;
};

__device__ __forceinline__ XcdBarrier xcd_barrier_post(unsigned* bar, volatile LAS unsigned* st) {
    XcdBarrier b; b.bar = bar; b.x = xb_xcc_id(); b.st = st;
    if (threadIdx.x == 0) (void)xb_add(&bar[XB_XCNT(b.x)], 1u);
    return b;
}
__device__ __forceinline__ void xcd_barrier_complete(unsigned* bar, unsigned x, unsigned& nloc, unsigned& nx) {
    const unsigned G = gridDim.x * gridDim.y * gridDim.z;
    unsigned sum, cnt, mine, sp = 0u;
    for (;;) {
        sum = 0u; cnt = 0u; mine = 0u;
#pragma unroll
        for (unsigned j = 0; j < 16; ++j) { const unsigned c = xb_ld(&bar[XB_XCNT(j)]); sum += c; cnt += (c > 0u) ? 1u : 0u; mine = (j == x) ? c : mine; }
        if (sum == G) break;
        __builtin_amdgcn_s_sleep(1);
        if ((++sp & 255u) == 0u) { if (xb_ld(&bar[XB_TMO])) break; if (sp > XB_SPIN_CAP) { atomicAdd(&bar[XB_TMO], 1u); break; } }
    }
    nloc = mine > 0u ? mine : 1u; nx = cnt > 0u ? cnt : 1u;
}

__device__ __forceinline__ void xcd_barrier(const XcdBarrier& b) {
    asm volatile("s_waitcnt vmcnt(0)" ::: "memory");
    __syncthreads();
    if (threadIdx.x == 0) {
        unsigned* bar = b.bar;
        __builtin_amdgcn_s_waitcnt(0);
        unsigned nloc = b.st[0], nx = b.st[1];
        if (nloc == 0u) { xcd_barrier_complete(bar, b.x, nloc, nx); b.st[0] = nloc; b.st[1] = nx; }
        const unsigned old = xb_add(&bar[XB_XSUB(b.x)], 1u);
        const unsigned gen = old / nloc;
        if (old + 1u == (gen + 1u) * nloc) {
            __builtin_amdgcn_fence(__ATOMIC_RELEASE, "agent");
            asm volatile("s_waitcnt vmcnt(0)" ::: "memory");
            const unsigned og = xb_add(&bar[XB_TOP], 1u);
            const unsigned tg = og / nx;
            if (og + 1u == (tg + 1u) * nx) xb_add(&bar[XB_TOPGEN], 1u);
            else XB_SPIN(xb_ld(&bar[XB_TOPGEN]) == tg, bar);
            __builtin_amdgcn_fence(__ATOMIC_ACQUIRE, "agent");
            xb_add(&bar[XB_XGEN(b.x)], 1u);
            asm volatile("s_waitcnt vmcnt(0)" ::: "memory");
        } else {
            XB_SPIN(xb_ld(&bar[XB_XGEN(b.x)]) == gen, bar);
            __builtin_amdgcn_fence(__ATOMIC_ACQUIRE, "agent");
            asm volatile("s_waitcnt vmcnt(0)" ::: "memory");
        }
    }
    __syncthreads();
}


struct Frame {
    LAS unsigned char* lds;
    volatile LAS unsigned* MISC;
    gu32* ctl;
    int tid, lane, wave;
    int vcu, G;
};
__device__ __forceinline__ float wave_sum(float v) {
#pragma unroll
    for (int o = 1; o < 64; o <<= 1) v += __shfl_xor(v, o);
    return v;
}
__device__ __forceinline__ void p0_transpose_tile(const float* Wt, int N, bf16* WTt, int K, LAS float* scr, int lane) {
    float tv[32];
#pragma unroll
    for (int i = 0; i < 32; ++i) tv[i] = __builtin_nontemporal_load(&Wt[(size_t)(2 * i + (lane >> 5)) * N + (lane & 31)]);
#pragma unroll
    for (int i = 0; i < 32; ++i) scr[(2 * i + (lane >> 5)) * 33 + (lane & 31)] = tv[i];
    LDS_WAIT(); asm volatile("" ::: "memory");
    const int c = lane & 7;
#pragma unroll
    for (int j = 0; j < 4; ++j) { const int n = (lane >> 3) + 8 * j; const LAS float* s = scr + (8 * c) * 33 + n;
        v4u o; o.x = pk2(s[0 * 33], s[1 * 33]); o.y = pk2(s[2 * 33], s[3 * 33]); o.z = pk2(s[4 * 33], s[5 * 33]); o.w = pk2(s[6 * 33], s[7 * 33]);
        *(GAS v4u*)(WTt + (size_t)n * K + 8 * c) = o; }
    LDS_WAIT(); asm volatile("" ::: "memory");
}


#define HG_MFMA(a, b, c) __builtin_amdgcn_mfma_f32_16x16x32_bf16((a), (b), (c), 0, 0, 0)
namespace hg {
#ifndef HGP
#define HGP 0
#endif
constexpr int QT_OFF = 0, KT_OFF = 12288, KET_OFF = 22528, DEC_OFF = 34816, BUFSZ = 35328, SSQ_OFF = 2 * BUFSZ, RAW_OFF = SSQ_OFF + 2048, RAWSZ = 4 * 8704, OUT_OFF = RAW_OFF + 2 * RAWSZ, OUTSZ = 8704, PB_OFF = OUT_OFF + 2 * OUTSZ, LDS_NEED = PB_OFF + 2048;
constexpr int RF_OFF = 0, RQ_OFF = 8704, RV_OFF = 17408, RG_OFF = 26112;
constexpr int PT = 272, PC = 96, PCK = 80;
struct Raw { v4u f, q, v, g; };
template <bool FULL>
__device__ __forceinline__ void load_raw(Raw& R, const bf16* PROJ, size_t rowc, int h, int tid) {
    const size_t bb = rowc / T, tt = rowc - bb * T;
    const bf16* p = PROJ + PJ_XH + ((bb * 4 + h) * T + tt) * 128 + (size_t)tid * 8;
    if (FULL) { R.f = __builtin_nontemporal_load((const GAS v4u*)(p + PJ_XSZ)); R.v = __builtin_nontemporal_load((const GAS v4u*)(p + 2 * PJ_XSZ)); R.q = __builtin_nontemporal_load((const GAS v4u*)p); R.g = __builtin_nontemporal_load((const GAS v4u*)(p + 3 * PJ_XSZ)); }
    else { R.f = *(const GAS v4u*)(p + PJ_XSZ); R.v = *(const GAS v4u*)(p + 2 * PJ_XSZ); }
}
template <bool FULL>
__device__ __forceinline__ void store_raw(const Raw& R, LAS unsigned char* raw, int tid) {
    LAS unsigned char* d = raw + (tid >> 4) * PT + 16 * (tid & 15);
    *(LAS v4u*)(d + RF_OFF) = R.f; *(LAS v4u*)(d + RV_OFF) = R.v; if (FULL) { *(LAS v4u*)(d + RQ_OFF) = R.q; *(LAS v4u*)(d + RG_OFF) = R.g; }
}
__device__ __forceinline__ s16x4 vtr16(const LAS unsigned char* p) { return __builtin_bit_cast(s16x4, __builtin_amdgcn_ds_read_tr16_b64_v4i16((LAS v4i16_t*)p)); }
template <bool FULL>
__device__ __forceinline__ void prep(const LAS unsigned char* raw, LAS unsigned char* buf, float lb, int w, int r16, int q, float& Dacc) {
    const int key = 16 * w + r16;
    const LAS unsigned char* tp = raw + (8 * q + (r16 >> 2)) * PT + 32 * w + 8 * (r16 & 3);
    const v2u F0 = __builtin_bit_cast(v2u, vtr16(tp + RF_OFF)), F1 = __builtin_bit_cast(v2u, vtr16(tp + RF_OFF + 4 * PT));
    const float fx[8] = {bflo(F0.x), bfhi(F0.x), bflo(F0.y), bfhi(F0.y), bflo(F1.x), bfhi(F1.x), bflo(F1.y), bfhi(F1.y)};
    float fv[8], P[8];
#pragma unroll
    for (int i = 0; i < 8; ++i) fv[i] = lb + (1.0f - lb) * __builtin_amdgcn_rcpf(1.0f + __expf(-fx[i]));
    P[0] = fv[0];
#pragma unroll
    for (int i = 1; i < 8; ++i) P[i] = P[i - 1] * fv[i];
    const float gt = P[7];
    const float t0 = __shfl(gt, r16), t1 = __shfl(gt, r16 + 16), t2 = __shfl(gt, r16 + 32), t3 = __shfl(gt, r16 + 48);
    const float excl = (q > 0 ? t0 : 1.0f) * (q > 1 ? t1 : 1.0f) * (q > 2 ? t2 : 1.0f);
    const float Plast = (t0 * t1) * (t2 * t3);
    float ke[8], kd[8], qd[8];
    float qx[8] = {0.f, 0.f, 0.f, 0.f, 0.f, 0.f, 0.f, 0.f};
    if (FULL) { const v2u Q0 = __builtin_bit_cast(v2u, vtr16(tp + RQ_OFF)), Q1 = __builtin_bit_cast(v2u, vtr16(tp + RQ_OFF + 4 * PT));
        qx[0] = bflo(Q0.x); qx[1] = bfhi(Q0.x); qx[2] = bflo(Q0.y); qx[3] = bfhi(Q0.y); qx[4] = bflo(Q1.x); qx[5] = bfhi(Q1.x); qx[6] = bflo(Q1.y); qx[7] = bfhi(Q1.y); }
#pragma unroll
    for (int i = 0; i < 8; ++i) P[i] *= excl;
    float rP[8]; rP[7] = __builtin_amdgcn_rcpf(P[7]);
#pragma unroll
    for (int i = 7; i > 0; --i) rP[i - 1] = rP[i] * fv[i];
#pragma unroll
    for (int i = 0; i < 8; ++i) { kd[i] = (1.0f - fv[i]) * rP[i]; ke[i] = kd[i] * Plast;
        if (FULL) qd[i] = qx[i] * __builtin_amdgcn_rcpf(1.0f + __expf(-qx[i])) * P[i]; }
    *(LAS v4u*)(buf + KET_OFF + key * PC + 16 * q) = (v4u){cvtpk_s(ke[0], ke[1]), cvtpk_s(ke[2], ke[3]), cvtpk_s(ke[4], ke[5]), cvtpk_s(ke[6], ke[7])};
    if (FULL) { *(LAS v4u*)(buf + KT_OFF + key * PCK + 16 * q) = (v4u){cvtpk_s(kd[0], kd[1]), cvtpk_s(kd[2], kd[3]), cvtpk_s(kd[4], kd[5]), cvtpk_s(kd[6], kd[7])};
        *(LAS v4u*)(buf + QT_OFF + key * PC + 16 * q) = (v4u){cvtpk_s(qd[0], qd[1]), cvtpk_s(qd[2], qd[3]), cvtpk_s(qd[4], qd[5]), cvtpk_s(qd[6], qd[7])}; }
    if (q == 0) *(LAS float*)(buf + DEC_OFF + 4 * key) = Plast;
    Dacc *= Plast;
}
__device__ __forceinline__ void prep_state(const LAS unsigned char* raw, LAS unsigned char* buf, float lb, int w, int r16, int q, float& Dacc) {
    const int key = 16 * w + r16;
    const LAS unsigned char* tp = raw + (8 * q + (r16 >> 2)) * PT + 32 * w + 8 * (r16 & 3);
    const v2u F0 = __builtin_bit_cast(v2u, vtr16(tp)), F1 = __builtin_bit_cast(v2u, vtr16(tp + 4 * PT));
    const float fx[8] = {bflo(F0.x), bfhi(F0.x), bflo(F0.y), bfhi(F0.y), bflo(F1.x), bfhi(F1.x), bflo(F1.y), bfhi(F1.y)};
    float fv[8], Q[8];
#pragma unroll
    for (int i = 0; i < 8; ++i) fv[i] = lb + (1.0f - lb) * __builtin_amdgcn_rcpf(1.0f + __expf(-fx[i]));
    Q[7] = 1.0f;
#pragma unroll
    for (int i = 7; i > 0; --i) Q[i - 1] = Q[i] * fv[i];
    const float gt = Q[0] * fv[0];
    const float t0 = __shfl(gt, r16), t1 = __shfl(gt, r16 + 16), t2 = __shfl(gt, r16 + 32), t3 = __shfl(gt, r16 + 48);
    const float sfx = (q < 1 ? t1 : 1.0f) * (q < 2 ? t2 : 1.0f) * (q < 3 ? t3 : 1.0f);
    const float Plast = (t0 * t1) * (t2 * t3);
    float ke[8];
#pragma unroll
    for (int i = 0; i < 8; ++i) ke[i] = (1.0f - fv[i]) * (Q[i] * sfx);
    *(LAS v4u*)(buf + KET_OFF + key * PC + 16 * q) = (v4u){cvtpk_s(ke[0], ke[1]), cvtpk_s(ke[2], ke[3]), cvtpk_s(ke[4], ke[5]), cvtpk_s(ke[6], ke[7])};
    if (q == 0) *(LAS float*)(buf + DEC_OFF + 4 * key) = Plast;
    Dacc *= Plast;
}
#define HG_MFMA(a, b, c) __builtin_amdgcn_mfma_f32_16x16x32_bf16((a), (b), (c), 0, 0, 0)
__device__ __forceinline__ bf16x8 cat8(s16x4 lo, s16x4 hi) { return __builtin_shufflevector(lo, hi, 0, 1, 2, 3, 4, 5, 6, 7); }
__device__ __forceinline__ bf16x8 pack8(f32x4 lo, f32x4 hi) { v4u p = (v4u){cvtpk_s(lo[0], lo[1]), cvtpk_s(lo[2], lo[3]), cvtpk_s(hi[0], hi[1]), cvtpk_s(hi[2], hi[3])}; return __builtin_bit_cast(bf16x8, p); }
__device__ __forceinline__ float silu_g(float g) { return g * __builtin_amdgcn_rcpf(1.0f + __expf(-g)); }
__device__ __forceinline__ void finish(const LAS float* ssqp, f32x4 oa, f32x4 ob, v2u g0, v2u g1, f32x4 gn4, LAS unsigned char* outt, int w, int r16, int q) {
#pragma unroll
    for (int ct = 0; ct < 2; ++ct) { float tot = 0.f;
#pragma unroll
        for (int ww = 0; ww < 8; ++ww) tot += ssqp[ww * 32 + 16 * ct + r16];
        const float rstd = rsqrtf(tot * (1.f / 128.f) + NORM_EPS);
        const f32x4 o = ct ? ob : oa; const v2u gg = ct ? g1 : g0;
        const float y0 = o[0] * rstd * gn4[0] * silu_g(bflo(gg.x)), y1 = o[1] * rstd * gn4[1] * silu_g(bfhi(gg.x));
        const float y2 = o[2] * rstd * gn4[2] * silu_g(bflo(gg.y)), y3 = o[3] * rstd * gn4[3] * silu_g(bfhi(gg.y));
        *(LAS v2u*)(outt + (16 * ct + r16) * PT + 2 * (16 * w + 4 * q)) = (v2u){cvtpk_s(y0, y1), cvtpk_s(y2, y3)}; }
}
__device__ __forceinline__ void flush_out(const LAS unsigned char* outt, bf16* dst_row0, int tid) {
    *(GAS v4u*)(dst_row0 + (size_t)(tid >> 4) * D + 8 * (tid & 15)) = *(const LAS v4u*)(outt + (tid >> 4) * PT + 16 * (tid & 15));
}

__device__ __forceinline__ void atile(const LAS unsigned char* buf, LAS unsigned char* pb, int w, int l, int r16, int q) {
    if (w < 3) {
        const LAS unsigned char* ktr = buf + KT_OFF + (4 * q + (r16 >> 2)) * PCK + 8 * (r16 & 3) + (w == 2 ? 32 : 0);
        const LAS unsigned char* qtr = buf + QT_OFF + (4 * q + (r16 >> 2)) * PC + 8 * (r16 & 3) + (w >= 1 ? 32 : 0);
        f32x4 a = (f32x4){0.f, 0.f, 0.f, 0.f};
#pragma unroll
        for (int ks = 0; ks < 4; ++ks) a = HG_MFMA(cat8(vtr16(ktr + 32 * ks * PCK), vtr16(ktr + (32 * ks + 16) * PCK)), cat8(vtr16(qtr + 32 * ks * PC), vtr16(qtr + (32 * ks + 16) * PC)), a);
        if (w != 1) {
#pragma unroll
            for (int r = 0; r < 4; ++r) a[r] = ((4 * q + r) <= r16) ? a[r] : 0.f; }
        *(LAS v2u*)(pb + 32 * l + (w == 0 ? 0 : 8 + 8 * w)) = (v2u){cvtpk_s(a[0], a[1]), cvtpk_s(a[2], a[3])};
    }
}
#define HG_BAR() asm volatile("s_waitcnt lgkmcnt(0)\n\ts_barrier" ::: "memory")
#define HG_BODY(NN, RLOAD, RSTORE) do { const int n = (NN); \
        LAS unsigned char* buf = lds + (n & 1) * BUFSZ; \
        const LAS unsigned char* rawc = lds + RAW_OFF + (n & 1) * RAWSZ; \
        load_raw<FULL>(RLOAD, PROJ, row0 + 32 * (n + 3 < 32 ? n + 3 : 31), h, tid); \
        f32x4 o0 = (f32x4){0.f, 0.f, 0.f, 0.f}, o1 = o0; v2u g0 = (v2u){0u, 0u}, g1 = g0; \
        const LAS unsigned char* vtr = rawc + RV_OFF + (r16 >> 2) * PT + 32 * w + 8 * (r16 & 3); \
        if (FULL) { \
            g0 = *(const LAS v2u*)(rawc + RG_OFF + r16 * PT + 2 * (16 * w + 4 * q)); g1 = *(const LAS v2u*)(rawc + RG_OFF + (16 + r16) * PT + 2 * (16 * w + 4 * q)); \
            const LAS unsigned char* qt2 = buf + QT_OFF + (4 * q + (r16 >> 2)) * PC + 8 * (r16 & 3); \
            const v2u pa = *(const LAS v2u*)(lds + PB_OFF + 32 * l); \
            const bf16x8 pb0 = __builtin_bit_cast(bf16x8, ((v4u){pa.x, pa.y, 0u, 0u})), pb1 = *(const LAS bf16x8*)(lds + PB_OFF + 32 * l + 16); \
            const bf16x8 va = cat8(vtr16(vtr + (4 * q) * PT), vtr16(vtr + (16 + 4 * q) * PT)); \
            o0 = HG_MFMA(va, pb0, o0); o1 = HG_MFMA(va, pb1, o1); \
_Pragma("unroll") \
            for (int i = 0; i < 4; ++i) { \
                const bf16x8 sa = pack8(S[2 * i], S[2 * i + 1]); \
                const bf16x8 b0 = cat8(vtr16(qt2 + 32 * i * PC), vtr16(qt2 + (32 * i + 16) * PC)), b1 = cat8(vtr16(qt2 + 32 * i * PC + 32), vtr16(qt2 + (32 * i + 16) * PC + 32)); \
                o0 = HG_MFMA(sa, b0, o0); o1 = HG_MFMA(sa, b1, o1); } \
            float p0 = (o0[0] * o0[0] + o0[1] * o0[1]) + (o0[2] * o0[2] + o0[3] * o0[3]), p1 = (o1[0] * o1[0] + o1[1] * o1[1]) + (o1[2] * o1[2] + o1[3] * o1[3]); \
            p0 += __shfl_xor(p0, 16); p0 += __shfl_xor(p0, 32); p1 += __shfl_xor(p1, 16); p1 += __shfl_xor(p1, 32); \
            if (q == 0) { ssq[((n & 1) * 8 + w) * 32 + r16] = p0; ssq[((n & 1) * 8 + w) * 32 + 16 + r16] = p1; } \
        } \
        { \
            const bf16x8 vb = cat8(vtr16(vtr + (8 * q) * PT), vtr16(vtr + (8 * q + 4) * PT)); \
_Pragma("unroll") \
            for (int kt = 0; kt < 8; ++kt) { const f32x4 d4 = *(const LAS f32x4*)(buf + DEC_OFF + 4 * (16 * kt + 4 * q)); \
                const bf16x8 ka = *(const LAS bf16x8*)(buf + KET_OFF + (16 * kt + r16) * PC + 16 * q); \
                S[kt] = HG_MFMA(ka, vb, S[kt] * d4); } \
        } \
        HG_BAR(); \
        if (n + 1 < 32) prep<FULL>(lds + RAW_OFF + ((n + 1) & 1) * RAWSZ, lds + ((n + 1) & 1) * BUFSZ, lb, w, r16, q, Dacc); \
        if (FULL && n > 0) flush_out(lds + OUT_OFF + ((n - 1) & 1) * OUTSZ, orow + (size_t)(32 * (n - 1)) * D, tid); \
        HG_BAR(); \
        if (FULL) finish(ssq + (n & 1) * 256, o0, o1, g0, g1, gn4, lds + OUT_OFF + (n & 1) * OUTSZ, w, r16, q); \
        store_raw<FULL>(RSTORE, lds + RAW_OFF + (n & 1) * RAWSZ, tid); \
        if (FULL && n + 1 < 32) atile(lds + ((n + 1) & 1) * BUFSZ, lds + PB_OFF, w, l, r16, q); \
        HG_BAR(); \
    } while (0)
template <bool FULL, int NCH = 32>
__device__ __forceinline__ void unit(LAS unsigned char* lds, int tid, int un_, const bf16* PROJ, const float* lbv, float* Ubuf, float* Dbuf, const float* gnorm, bf16* MIXIN) {
    const int w = __builtin_amdgcn_readfirstlane(tid >> 6), l = tid & 63, r16 = l & 15, q = l >> 4;
    const int b = un_ >> 5, h = (un_ >> 3) & 3, seg = un_ & 7;
    const size_t row0 = (size_t)b * T + (size_t)seg * 1024;
    const float lb = lbv[h * 128 + 16 * w + r16];
    LAS float* ssq = (LAS float*)(lds + SSQ_OFF);
    f32x4 S[8];
#pragma unroll
    for (int kt = 0; kt < 8; ++kt) S[kt] = (f32x4){0.f, 0.f, 0.f, 0.f};
    Raw R, R1;
    load_raw<FULL>(R, PROJ, row0, h, tid);
    if (FULL) {
        f32x4 un[8], dn[8];
        if (seg > 0) { const float* Uj = Ubuf + ((size_t)(un_ - seg) * 8 + w) * 2048; const float* Dj = Dbuf + (size_t)(un_ - seg) * 128;
#pragma unroll
            for (int kt = 0; kt < 8; ++kt) { dn[kt] = *(const f32x4*)(Dj + 16 * kt + 4 * q); un[kt] = *(const f32x4*)(Uj + (kt * 64 + l) * 4); } }
        for (int j = 0; j < seg; ++j) {
            f32x4 uc[8], dc[8];
#pragma unroll
            for (int kt = 0; kt < 8; ++kt) { uc[kt] = un[kt]; dc[kt] = dn[kt]; }
            if (j + 1 < seg) { const float* Uj = Ubuf + ((size_t)(un_ - seg + j + 1) * 8 + w) * 2048; const float* Dj = Dbuf + (size_t)(un_ - seg + j + 1) * 128;
#pragma unroll
                for (int kt = 0; kt < 8; ++kt) { dn[kt] = *(const f32x4*)(Dj + 16 * kt + 4 * q); un[kt] = *(const f32x4*)(Uj + (kt * 64 + l) * 4); } }
#pragma unroll
            for (int kt = 0; kt < 8; ++kt) S[kt] = S[kt] * dc[kt] + uc[kt];
        }
    }
    float Dacc = 1.0f;
    f32x4 gn4 = (f32x4){0.f, 0.f, 0.f, 0.f};
    if (FULL) gn4 = *(const f32x4*)(gnorm + h * 128 + 16 * w + 4 * q);
    store_raw<FULL>(R, lds + RAW_OFF, tid);
    load_raw<FULL>(R, PROJ, row0 + 32, h, tid);
    __syncthreads();
    prep<FULL>(lds + RAW_OFF, lds, lb, w, r16, q, Dacc);
    store_raw<FULL>(R, lds + RAW_OFF + RAWSZ, tid);
    load_raw<FULL>(R, PROJ, row0 + 64, h, tid);
    __syncthreads();
    if (FULL) { atile(lds, lds + PB_OFF, w, l, r16, q); __syncthreads(); }
    bf16* const orow = MIXIN + row0 * D + 512 + h * 128;
    for (int n2 = 0; n2 < NCH; n2 += 2) { HG_BODY(n2, R1, R); HG_BODY(n2 + 1, R, R1); }
    if (FULL) { __syncthreads(); flush_out(lds + OUT_OFF + OUTSZ, orow + (size_t)(32 * 31) * D, tid); }
    if (!FULL) {
        float* Uo = Ubuf + ((size_t)un_ * 8 + w) * 2048;
#pragma unroll
        for (int kt = 0; kt < 8; ++kt) *(f32x4*)(Uo + (kt * 64 + l) * 4) = S[kt];
        if (q == 0) Dbuf[(size_t)un_ * 128 + 16 * w + r16] = Dacc;
    }
    __syncthreads();
}
constexpr int SP_RAWC = 2 * 8704, SP_RAWP = 2 * SP_RAWC, SP_IMG_OFF = 3 * SP_RAWP, SP_IMG = 12800, SP_NEED = SP_IMG_OFF + 4 * SP_IMG;
struct Raw2 { v4u f0, v0, f1, v1; };
__device__ __forceinline__ void sp_load(Raw2& R, const bf16* PROJ, size_t rowc, int h, int tid) {
    const size_t bb = rowc / T, tt = rowc - bb * T;
    const bf16* p = PROJ + PJ_XH + ((bb * 4 + h) * T + tt) * 128 + (size_t)tid * 8;
    R.f0 = *(const GAS v4u*)(p + PJ_XSZ); R.v0 = *(const GAS v4u*)(p + 2 * PJ_XSZ); R.f1 = *(const GAS v4u*)(p + PJ_XSZ + 32 * 128); R.v1 = *(const GAS v4u*)(p + 2 * PJ_XSZ + 32 * 128);
}
__device__ __forceinline__ void sp_store(const Raw2& R, LAS unsigned char* raw, int tid) {
    LAS unsigned char* d = raw + (tid >> 4) * PT + 16 * (tid & 15);
    *(LAS v4u*)d = R.f0; *(LAS v4u*)(d + 8704) = R.v0; *(LAS v4u*)(d + SP_RAWC) = R.f1; *(LAS v4u*)(d + SP_RAWC + 8704) = R.v1;
}
#define SP_UPD(IMGP, RAWP) do { const LAS unsigned char* im_ = (IMGP); const LAS unsigned char* vt_ = (RAWP) + 8704 + (r16 >> 2) * PT + 32 * w + 8 * (r16 & 3); \
        const bf16x8 vb = cat8(vtr16(vt_ + (8 * q) * PT), vtr16(vt_ + (8 * q + 4) * PT)); \
_Pragma("unroll") \
        for (int kt = 0; kt < 8; ++kt) { const f32x4 d4 = *(const LAS f32x4*)(im_ + 12288 + 4 * (16 * kt + 4 * q)); \
            const bf16x8 ka = *(const LAS bf16x8*)(im_ + (16 * kt + r16) * PC + 16 * q); \
            S[kt] = HG_MFMA(ka, vb, S[kt] * d4); } } while (0)
#define SP_PBUF(k) (lds + SP_IMG_OFF + (k) * SP_IMG - KET_OFF)
#define SP_STEP(MM, RLOAD, RSTORE) do { const int m = (MM), pp = m & 1; \
        sp_load(RLOAD, PROJ, row0 + 64 * (m + 3 < 16 ? m + 3 : 15), h, tid); \
        SP_UPD(lds + SP_IMG_OFF + (2 * pp) * SP_IMG, lds + o0); \
        SP_UPD(lds + SP_IMG_OFF + (2 * pp + 1) * SP_IMG, lds + o0 + SP_RAWC); \
        if (m + 1 < 16) { prep_state(lds + o1, SP_PBUF(2 * (pp ^ 1)), lb, w, r16, q, Dacc); prep_state(lds + o1 + SP_RAWC, SP_PBUF(2 * (pp ^ 1) + 1), lb, w, r16, q, Dacc); } \
        if (m + 2 < 16) sp_store(RSTORE, lds + o2, tid); \
        HG_BAR(); \
        { const int t_ = o0; o0 = o1; o1 = o2; o2 = t_; } \
    } while (0)
__device__ __forceinline__ void unit_state(LAS unsigned char* lds, int tid, int un_, const bf16* PROJ, const float* lbv, float* Ubuf, float* Dbuf) {
    const int w = __builtin_amdgcn_readfirstlane(tid >> 6), l = tid & 63, r16 = l & 15, q = l >> 4;
    const int b = un_ >> 5, h = (un_ >> 3) & 3, seg = un_ & 7;
    const size_t row0 = (size_t)b * T + (size_t)seg * 1024;
    const float lb = lbv[h * 128 + 16 * w + r16];
    f32x4 S[8];
#pragma unroll
    for (int kt = 0; kt < 8; ++kt) S[kt] = (f32x4){0.f, 0.f, 0.f, 0.f};
    float Dacc = 1.0f;
    Raw2 RA, RB;
    sp_load(RA, PROJ, row0, h, tid);
    sp_store(RA, lds, tid);
    sp_load(RA, PROJ, row0 + 64, h, tid);
    __syncthreads();
    prep_state(lds, SP_PBUF(0), lb, w, r16, q, Dacc); prep_state(lds + SP_RAWC, SP_PBUF(1), lb, w, r16, q, Dacc);
    sp_store(RA, lds + SP_RAWP, tid);
    sp_load(RA, PROJ, row0 + 128, h, tid);
    __syncthreads();
    int o0 = 0, o1 = SP_RAWP, o2 = 2 * SP_RAWP;
    for (int m2 = 0; m2 < 16; m2 += 2) { SP_STEP(m2, RB, RA); SP_STEP(m2 + 1, RA, RB); }
    float* Uo = Ubuf + ((size_t)un_ * 8 + w) * 2048;
#pragma unroll
    for (int kt = 0; kt < 8; ++kt) *(f32x4*)(Uo + (kt * 64 + l) * 4) = S[kt];
    if (q == 0) Dbuf[(size_t)un_ * 128 + 16 * w + r16] = Dacc;
    __syncthreads();
}
}

struct Args { const float* in[21]; float* out; unsigned char* ws; int ph_lo, ph_hi; };

__global__ void __launch_bounds__(NWAVES * 64, 2) fwd(Args args) {
    extern __shared__ __attribute__((aligned(16))) unsigned char lds[];
    Frame F;
    F.lds = (LAS unsigned char*)lds;
    F.MISC = (volatile LAS unsigned*)(F.lds + MISC_OFF);
    F.tid = threadIdx.x; F.lane = F.tid & 63; F.wave = __builtin_amdgcn_readfirstlane(F.tid >> 6);
    F.G = gridDim.x; { const int bx = blockIdx.x; F.vcu = (F.G % 8 == 0) ? (bx % 8) * (F.G / 8) + bx / 8 : bx; }
    unsigned char* ws = args.ws;
    F.ctl = (gu32*)(ws + WS_CTL);
    for (int u = F.tid; u < (LDS_BYTES - LDSCTL_OFF) / 4; u += NWAVES * 64) ((LAS unsigned*)(F.lds + LDSCTL_OFF))[u] = 0u;
    __syncthreads();
    XcdBarrier bar; bar.bar = (unsigned*)(F.ctl + CW_BAR); bar.x = 0; bar.st = nullptr;
    if (N_LAUNCHES == 1) bar = xcd_barrier_post((unsigned*)(F.ctl + CW_BAR), F.MISC + 8);
#define GRID_BAR() do { if (N_LAUNCHES == 1) xcd_barrier(bar); } while (0)
    const int lo = args.ph_lo, hi = args.ph_hi;
#define IN(k) (lo <= (k) && (k) < hi)
#define BOTH(k) (IN(k) && IN((k) + 1))
#ifndef REPMASK
#define REPMASK 0
#endif
#define REPS(k) ((((REPMASK) >> (k)) & 1) + 1)

    const float* x = args.in[0];
    float* mod = (float*)(ws + WS_MOD);
    float* lbv = (float*)(ws + WS_LB);
    bf16* Win_t = (bf16*)(ws + WS_WIN); bf16* Wout_t = (bf16*)(ws + WS_WOUT); bf16* Wgu_t = (bf16*)(ws + WS_WGU); bf16* Wd_t = (bf16*)(ws + WS_WD);
    bf16* WrT = (bf16*)(ws + WS_WRT);
 float* Useg = (float*)(ws + WS_U); float* Dseg = (float*)(ws + WS_DSEG);
    v2i* list2 = (v2i*)(ws + WS_LIST); v2i* tokpos = (v2i*)(ws + WS_TOKPOS); bf16* ACT = (bf16*)(ws + WS_ACT); unsigned char* Y8 = (unsigned char*)(ws + WS_Y); gu32* ecnt = F.ctl + CW_CNT;
    bf16* Hb = (bf16*)(ws + WS_H); bf16* PROJ = (bf16*)(ws + WS_PROJ); bf16* MIXIN = (bf16*)(ws + WS_MIXIN); bf16* X1 = (bf16*)(ws + WS_X1);
    bf16* MIX = Hb; bf16* H2 = MIXIN;
    const int gw = F.vcu * NWAVES + F.wave, NGW = F.G * NWAVES;

    if (IN(0)) _Pragma("unroll") for (int rep_ = 0; rep_ < REPS(0); ++rep_) {
        F.lane = lane_id_v(); F.tid = F.wave * 64 + F.lane;
        LAS float* scr = (LAS float*)(F.lds + RING_OFF + F.wave * 16384);
        constexpr int I_IN = (D / 64) * (NPROJ / 32), I_OUT = (D / 64) * (D / 32), I_G = NEXP * (D / 64) * (FF / 32), I_D = NEXP * (FF / 64) * (D / 32);
        for (int it = gw; it < I_IN + I_OUT + 2 * I_G + I_D; it += NGW) {
            int r = it;
            if (r < I_IN) { const int nblk = NPROJ / 32, k0 = 64 * (r / nblk), n0 = 32 * (r % nblk);
                p0_transpose_tile(args.in[8] + (size_t)k0 * NPROJ + n0, NPROJ, Win_t + (size_t)n0 * D + k0, D, scr, F.lane); continue; } r -= I_IN;
            if (r < I_OUT) { const int nblk = D / 32, k0 = 64 * (r / nblk), n0 = 32 * (r % nblk);
                p0_transpose_tile(args.in[13] + (size_t)k0 * D + n0, D, Wout_t + (size_t)n0 * D + k0, D, scr, F.lane); continue; } r -= I_OUT;
            if (r < 2 * I_G) { const int up = r >= I_G; if (up) r -= I_G;
                const int e = r / 128, q = r % 128, k0 = 64 * (q / 8), n0 = 32 * (q % 8);
                const int drow = (n0 >> 7) * 256 + (up ? 128 : 0) + (n0 & 127);
                p0_transpose_tile(args.in[up ? 19 : 18] + (size_t)e * D * FF + (size_t)k0 * FF + n0, FF, Wgu_t + ((size_t)e * 512 + drow) * D + k0, D, scr, F.lane); continue; } r -= 2 * I_G;
            { const int e = r / 128, q = r % 128, k0 = 64 * (q / 32), n0 = 32 * (q % 32);
              p0_transpose_tile(args.in[20] + (size_t)e * FF * D + (size_t)k0 * D + n0, D, Wd_t + ((size_t)e * D + n0) * FF + k0, FF, scr, F.lane); }
        }
        __syncthreads();
        F.lane = lane_id_v(); F.tid = F.wave * 64 + F.lane;
        LAS float* cs = (LAS float*)(F.lds);
        LAS float* red = (LAS float*)(F.lds + 32768);
        _Pragma("unroll") for (int rm_ = 0; rm_ < REPS(12); ++rm_)
        for (int item = blockIdx.x; item < 192; item += F.G) {
            for (int i = F.tid; i < 8 * 1024; i += 512) { const float cv = args.in[1][i]; cs[i] = cv * sigmoidf_(cv); }
            __syncthreads();
            float a[8];
#pragma unroll
            for (int b = 0; b < 8; ++b) a[b] = 0.f;
            const int col = F.lane & 31, kb = 128 * F.wave + 64 * (F.lane >> 5);
            const float* wp = args.in[6] + (size_t)kb * 6144 + item * 32 + col;
#pragma unroll 1
            for (int k0 = 0; k0 < 64; k0 += 16) { float wv[16];
#pragma unroll
                for (int k = 0; k < 16; ++k) wv[k] = __builtin_nontemporal_load(&wp[(size_t)(k0 + k) * 6144]);
#pragma unroll
                for (int b = 0; b < 8; ++b)
#pragma unroll
                    for (int k4 = 0; k4 < 16; k4 += 4) { const f32x4 c4 = *(const LAS f32x4*)(cs + b * 1024 + kb + k0 + k4);
                        a[b] += c4[0] * wv[k4] + c4[1] * wv[k4 + 1] + c4[2] * wv[k4 + 2] + c4[3] * wv[k4 + 3]; } }
#pragma unroll
            for (int b = 0; b < 8; ++b) { a[b] += __shfl_xor(a[b], 32); if (F.lane < 32) red[(F.wave * 8 + b) * 32 + col] = a[b]; }
            __syncthreads();
            if (F.tid < 256) { const int b = F.tid >> 5, c = F.tid & 31; float s_ = args.in[7][item * 32 + c];
#pragma unroll
              for (int w = 0; w < 8; ++w) s_ += red[(w * 8 + b) * 32 + c];
              mod[b * 6144 + item * 32 + c] = s_; }
            __syncthreads();
        }
        for (int i = blockIdx.x * 512 + F.tid; i < 48 * 1024; i += F.G * 512) { const int n = i >> 10, k = i & 1023;
            const float wv = n < 4 ? args.in[14][k * 4 + n] : (n < 36 ? args.in[16][k * 32 + (n - 4)] : 0.f);
            const unsigned hi = f2bf(wv); const float lo = wv - bflo(hi);
            WrT[i] = (bf16)hi; WrT[48 * 1024 + i] = (bf16)f2bf(lo); }
        if (blockIdx.x == (unsigned)(F.G - 1)) { const int i = F.tid; const float a0 = args.in[11][i], a1 = args.in[11][512 + i]; lbv[i] = 1.0f / (1.0f + __expf(a1 - a0)); }
        if (BOTH(0)) GRID_BAR();
    }

    if (IN(1)) _Pragma("unroll") for (int rep_ = 0; rep_ < REPS(1); ++rep_) {
        F.lane = lane_id_v(); F.tid = F.wave * 64 + F.lane;
        const float* g1 = args.in[2];
        f32x4 vn[4];
        if (gw < M) { const GAS f32x4* xr = (const GAS f32x4*)(x + (size_t)gw * D) + F.lane;
#pragma unroll
            for (int j = 0; j < 4; ++j) vn[j] = __builtin_nontemporal_load(&xr[64 * j]); }
        for (int m = gw; m < M; m += NGW) {
            const int b = m / T;
            f32x4 v[4]; float s = 0.f;
#pragma unroll
            for (int j = 0; j < 4; ++j) { v[j] = vn[j]; s += (v[j].x * v[j].x + v[j].y * v[j].y) + (v[j].z * v[j].z + v[j].w * v[j].w); }
            if (m + NGW < M) { const GAS f32x4* xr = (const GAS f32x4*)(x + (size_t)(m + NGW) * D) + F.lane;
#pragma unroll
                for (int j = 0; j < 4; ++j) vn[j] = __builtin_nontemporal_load(&xr[64 * j]); }
            const float rstd = rsqrtf(wave_sum(s) * (1.f / D) + NORM_EPS);
            GAS v2u* o8 = (GAS v2u*)(Hb + (size_t)m * D) + F.lane;
#pragma unroll
            for (int j = 0; j < 4; ++j) { const int k = 4 * F.lane + 256 * j;
                const f32x4 g = *(const f32x4*)(g1 + k), sh = *(const f32x4*)(mod + b * 6144 + k), sc = *(const f32x4*)(mod + b * 6144 + 1024 + k);
                const f32x4 h = v[j] * rstd * g * (sc + 1.0f) + sh;
                v2u o; o.x = pk2(h.x, h.y); o.y = pk2(h.z, h.w); o8[64 * j] = o; }
        }
        if (BOTH(1)) GRID_BAR();
    }

    if (IN(2)) _Pragma("unroll") for (int rep_ = 0; rep_ < REPS(2); ++rep_) {
        F.lane = lane_id_v(); F.tid = F.wave * 64 + F.lane;
        pg8::PlainProb P{(const char*)Hb, (const char*)Win_t, D}; pg8::StaticOrder S; S.init(M, NPROJ, F.G, (int)blockIdx.x);
        pg8::EpiProj E{PROJ, T, PJ_KA, PJ_VA, PJ_XH, PJ_XSZ, F.lds + CS_OFF + F.wave * 2048};
        pg8::gemm_phase2<pg8::PlainProb, pg8::EpiProj, pg8::StaticOrder, true, true>(F.lds + RING_OFF, P, S, E, F.wave);
        if (BOTH(2)) GRID_BAR();
    }

    if (IN(3)) _Pragma("unroll") for (int rep_ = 0; rep_ < REPS(3); ++rep_) {
        F.lane = lane_id_v(); F.tid = F.wave * 64 + F.lane;
        static_assert(hg::LDS_NEED <= P3_LDS_END && hg::SP_NEED <= P3_LDS_END, "hgrn LDS");
        _Pragma("unroll") for (int rs_ = 0; rs_ < REPS(10); ++rs_)
        for (int un = blockIdx.x; un < 256; un += F.G) hg::unit_state(F.lds, F.tid, un, PROJ, lbv, Useg, Dseg);
        {
            LAS unsigned char* Ks = F.lds;
            LAS unsigned char* Vs = F.lds + 73728;
            LAS float* ssq = (LAS float*)(F.lds + 147456);
            static_assert(147456 + 4096 <= P3_LDS_END, "attention LDS");
            const float* sinks = args.in[9]; const float* anorm = args.in[10];
            const int h = F.wave, g = h >> 2, ql = F.lane & 31, hf = F.lane >> 5;
            const float LOG2E = 1.4426950408889634f;
            const float c1 = 0.125f * LOG2E, slope2 = exp2f(-(float)(h + 1)) * LOG2E, sink2 = sinks[h] * LOG2E;
            for (int item2 = blockIdx.x; item2 < REPS(11) * (M / 128); item2 += F.G) { const int item = item2 & (M / 128 - 1);
                const int b = item >> 6, nb = item & 63, t0 = nb * 128; const size_t row0 = (size_t)b * T + t0;
                __syncthreads();
                {
                    const unsigned kto = (unsigned)F.tid * 16u;
                    LAS unsigned char* kl = Ks + (F.tid >> 3) * 144 + 16 * (F.tid & 7); LAS unsigned char* vl = Vs + (F.tid >> 3) * 144 + 16 * (F.tid & 7);
#pragma unroll
                    for (int i = 0; i < 8; ++i) { const int gg = i >> 2, k64 = 64 * (i & 3);
                        const char* kb = (const char*)(PROJ + PJ_KA) + ((size_t)(b * 2 + gg) * T + t0 - 128 + k64) * 128;
                        const char* vb = (const char*)(PROJ + PJ_VA) + ((size_t)(b * 2 + gg) * T + t0 - 128 + k64) * 128;
                        v4u kv = (v4u){0u, 0u, 0u, 0u}, vv = kv;
                        if (nb > 0 || (i & 3) >= 2) { kv = *(const GAS v4u*)(kb + kto); vv = *(const GAS v4u*)(vb + kto); }
                        *(LAS v4u*)(kl + (gg * 256 + k64) * 144) = kv; *(LAS v4u*)(vl + (gg * 256 + k64) * 144) = vv; }
                }
                __syncthreads();
                bf16x8 qn[4];
                { const bf16* qp = PROJ + PJ_QA + ((size_t)(b * 8 + h) * T + t0 + ql) * 64 + 8 * hf;
#pragma unroll
                  for (int s4 = 0; s4 < 4; ++s4) qn[s4] = __builtin_nontemporal_load((const GAS bf16x8*)(qp + 16 * s4)); }
                for (int qt = 0; qt < 4; ++qt) {
                    bf16x8 qf[4];
#pragma unroll
                    for (int s4 = 0; s4 < 4; ++s4) qf[s4] = qn[s4];
                    if (qt < 3) { const bf16* qp = PROJ + PJ_QA + ((size_t)(b * 8 + h) * T + t0 + 32 * (qt + 1) + ql) * 64 + 8 * hf;
#pragma unroll
                      for (int s4 = 0; s4 < 4; ++s4) qn[s4] = __builtin_nontemporal_load((const GAS bf16x8*)(qp + 16 * s4)); }
                    f32x16 st[5];
#pragma unroll
                    for (int k5 = 0; k5 < 5; ++k5) { f32x16 a;
#pragma unroll
                        for (int r = 0; r < 16; ++r) a[r] = 0.f;
                        const LAS unsigned char* kp = Ks + (g * 256 + (qt + k5) * 32 + ql) * 144 + 16 * hf;
#pragma unroll
                        for (int s4 = 0; s4 < 4; ++s4) { const bf16x8 ka = *(const LAS bf16x8*)(kp + 32 * s4); a = __builtin_amdgcn_mfma_f32_32x32x16_bf16(ka, qf[s4], a, 0, 0, 0); }
                        st[k5] = a; }
                    float mx = sink2;
                    const float lb0 = -slope2 * (float)(ql + 128 - 4 * hf);
#pragma unroll
                    for (int k5 = 0; k5 < 5; ++k5) { const bool tile_ok = (nb > 0) || (qt + k5 >= 4); const float lbk = lb0 + slope2 * (float)(32 * k5);
#pragma unroll
                        for (int r = 0; r < 16; ++r) { const int c0 = (r & 3) + 8 * (r >> 2);
                            float v = st[k5][r] * c1 + (lbk + slope2 * (float)c0);
                            bool ok = tile_ok;
                            if (k5 == 0) ok = ok && (c0 + 4 * hf > ql);
                            if (k5 == 4) ok = ok && (c0 + 4 * hf <= ql);
                            v = ok ? v : -1.0e30f; st[k5][r] = v; mx = fmaxf(mx, v); } }
                    mx = fmaxf(mx, __shfl_xor(mx, 32));
                    float sum = 0.f;
#pragma unroll
                    for (int k5 = 0; k5 < 5; ++k5)
#pragma unroll
                        for (int r = 0; r < 16; ++r) { const float p = __builtin_amdgcn_exp2f(st[k5][r] - mx);   st[k5][r] = p; sum += p; }
                    sum += __shfl_xor(sum, 32); sum += __builtin_amdgcn_exp2f(sink2 - mx);
                    const float inv = 1.0f / sum;
                    f32x16 o0, o1;
#pragma unroll
                    for (int r = 0; r < 16; ++r) { o0[r] = 0.f; o1[r] = 0.f; }
#pragma unroll
                    for (int k5 = 0; k5 < 5; ++k5)
#pragma unroll
                        for (int s2 = 0; s2 < 2; ++s2) {
                            v4u pp; pp.x = cvtpk_s(st[k5][8 * s2 + 0], st[k5][8 * s2 + 1]); pp.y = cvtpk_s(st[k5][8 * s2 + 2], st[k5][8 * s2 + 3]);
                            pp.z = cvtpk_s(st[k5][8 * s2 + 4], st[k5][8 * s2 + 5]); pp.w = cvtpk_s(st[k5][8 * s2 + 6], st[k5][8 * s2 + 7]);
                            const bf16x8 pb = __builtin_bit_cast(bf16x8, pp);
                            const int kb = (qt + k5) * 32 + 16 * s2 + 4 * hf; const int i16 = F.lane & 15, dsel = (F.lane >> 4) & 1;
                            const LAS unsigned char* vp = Vs + (g * 256 + kb + (i16 >> 2)) * 144 + (16 * dsel + 4 * (i16 & 3)) * 2;
                            { const s16x4 lo = vtr16(vp), hi = vtr16(vp + 8 * 144);
                              const bf16x8 va = __builtin_shufflevector(lo, hi, 0, 1, 2, 3, 4, 5, 6, 7); o0 = __builtin_amdgcn_mfma_f32_32x32x16_bf16(va, pb, o0, 0, 0, 0); }
                            { const s16x4 lo = vtr16(vp + 64), hi = vtr16(vp + 64 + 8 * 144);
                              const bf16x8 va = __builtin_shufflevector(lo, hi, 0, 1, 2, 3, 4, 5, 6, 7); o1 = __builtin_amdgcn_mfma_f32_32x32x16_bf16(va, pb, o1, 0, 0, 0); }
                        }
                    float sq = 0.f;
                    bf16* op = MIXIN + (row0 + 32 * qt + ql) * D + h * 64 + 4 * hf;
#pragma unroll
                    for (int rg = 0; rg < 4; ++rg) {
                        const float a0 = o0[4 * rg] * inv, a1 = o0[4 * rg + 1] * inv, a2 = o0[4 * rg + 2] * inv, a3 = o0[4 * rg + 3] * inv;
                        const float b0 = o1[4 * rg] * inv, b1 = o1[4 * rg + 1] * inv, b2 = o1[4 * rg + 2] * inv, b3 = o1[4 * rg + 3] * inv;
                        sq += (a0 * a0 + a1 * a1) + (a2 * a2 + a3 * a3) + (b0 * b0 + b1 * b1) + (b2 * b2 + b3 * b3);
                        *(GAS v2u*)(op + 8 * rg) = (v2u){cvtpk_s(a0, a1), cvtpk_s(a2, a3)};
                        *(GAS v2u*)(op + 32 + 8 * rg) = (v2u){cvtpk_s(b0, b1), cvtpk_s(b2, b3)}; }
                    sq += __shfl_xor(sq, 32);
                    if (hf == 0) ssq[h * 128 + 32 * qt + ql] = sq;
                }
                __syncthreads();
                { const f32x4 n0 = *(const f32x4*)(anorm + 8 * F.lane), n1 = *(const f32x4*)(anorm + 8 * F.lane + 4);
#pragma unroll
                  for (int i0 = 0; i0 < 16; i0 += 8) {
                    v4u uu[8];
#pragma unroll
                    for (int i = 0; i < 8; ++i) uu[i] = *(const GAS v4u*)(MIXIN + (row0 + 16 * F.wave + i0 + i) * D + 8 * F.lane);
#pragma unroll
                    for (int i = 0; i < 8; ++i) { const int tt = 16 * F.wave + i0 + i;
                        float ss = 0.f;
#pragma unroll
                        for (int hh = 0; hh < 8; ++hh) ss += ssq[hh * 128 + tt];
                        const float rstd = rsqrtf(ss * (1.f / 512.f) + NORM_EPS);
                        const v4u u = uu[i];
                        v4u o; o.x = cvtpk_s(bflo(u.x) * rstd * n0.x, bfhi(u.x) * rstd * n0.y); o.y = cvtpk_s(bflo(u.y) * rstd * n0.z, bfhi(u.y) * rstd * n0.w);
                        o.z = cvtpk_s(bflo(u.z) * rstd * n1.x, bfhi(u.z) * rstd * n1.y); o.w = cvtpk_s(bflo(u.w) * rstd * n1.z, bfhi(u.w) * rstd * n1.w);
                        *(GAS v4u*)(MIXIN + (row0 + tt) * D + 8 * F.lane) = o; } } }
            }
        }
        if (BOTH(3)) GRID_BAR();
    }

    if (IN(4)) _Pragma("unroll") for (int rep_ = 0; rep_ < REPS(4); ++rep_) {
        F.lane = lane_id_v(); F.tid = F.wave * 64 + F.lane;
        for (int un = blockIdx.x; un < 256; un += F.G) hg::unit<true>(F.lds, F.tid, un, PROJ, lbv, Useg, Dseg, args.in[12], MIXIN);
#if defined(P4DUP) && P4DUP
        for (int un = blockIdx.x; un < 256; un += F.G) hg::unit<true, P4DUP>(F.lds, F.tid, un, PROJ, lbv, Useg, Dseg, args.in[12], Hb);
#endif
        if (BOTH(4)) GRID_BAR();
    }

    if (IN(5)) _Pragma("unroll") for (int rep_ = 0; rep_ < REPS(5); ++rep_) {
        F.lane = lane_id_v(); F.tid = F.wave * 64 + F.lane;
        pg8::PlainProb P{(const char*)MIXIN, (const char*)Wout_t, D}; pg8::StaticOrder S; S.init(M, D, F.G, (int)blockIdx.x);
        pg8::EpiBf16W E{MIX, D, F.lds + CS_OFF + F.wave * 2048};
        pg8::gemm_phase2<pg8::PlainProb, pg8::EpiBf16W, pg8::StaticOrder, true, true>(F.lds + RING_OFF, P, S, E, F.wave);
        if (BOTH(5)) GRID_BAR();
    }

    if (IN(6)) {
        F.lane = lane_id_v(); F.tid = F.wave * 64 + F.lane;
        const float* g1p = args.in[3]; const float* g2 = args.in[4]; const float* brg = args.in[15]; const float* bre = args.in[17];
        constexpr int APITCH = 2064;
        LAS unsigned char* Ahi = F.lds; LAS unsigned char* Alo = F.lds + 16 * APITCH;
        LAS float* part = (LAS float*)(F.lds + 2 * 16 * APITCH);
        LAS float* red = part + 8 * 16 * 48;
        const int r16 = F.lane & 15, q4 = F.lane >> 4;
        int my_m = -1, my_e1 = 0, my_e2 = 0, my_w1 = 0, my_w2 = 0, nstep = 0;
        const int ngrp = M / 16;
        bf16x8 rbh[4][3];
#pragma unroll
        for (int ks = 0; ks < 4; ++ks)
#pragma unroll
            for (int nt = 0; nt < 3; ++nt) { const bf16* wp = WrT + (size_t)(16 * nt + r16) * 1024 + 128 * F.wave + 32 * ks + 8 * q4;
                rbh[ks][nt] = *(const GAS bf16x8*)wp; }
        v2u mixn[2][4]; f32x4 xnx[2][4];
#define P6_FETCH(gg) do { _Pragma("unroll") for (int rr_ = 0; rr_ < 2; ++rr_) { const int m_ = (gg) * 16 + 2 * F.wave + rr_; \
            const GAS v2u* mr_ = (const GAS v2u*)(MIX + (size_t)m_ * D) + F.lane; const GAS f32x4* xr_ = (const GAS f32x4*)(x + (size_t)m_ * D) + F.lane; \
            _Pragma("unroll") for (int j = 0; j < 4; ++j) { mixn[rr_][j] = __builtin_nontemporal_load(&mr_[64 * j]); xnx[rr_][j] = __builtin_nontemporal_load(&xr_[64 * j]); } } } while (0)
        if ((int)blockIdx.x < ngrp) P6_FETCH((int)blockIdx.x);
        for (int grp = blockIdx.x; grp < ngrp; grp += F.G) {
            const int m0 = grp * 16; const int b = m0 / T; const float* mb = mod + b * 6144;
            {
                f32x4 v[2][4]; float s1[2] = {0.f, 0.f}, s2[2] = {0.f, 0.f};
#pragma unroll
                for (int rr = 0; rr < 2; ++rr)
#pragma unroll
                    for (int j = 0; j < 4; ++j) { const v2u u = mixn[rr][j]; v[rr][j] = (f32x4){bflo(u.x), bfhi(u.x), bflo(u.y), bfhi(u.y)};
                        s1[rr] += (v[rr][j].x * v[rr][j].x + v[rr][j].y * v[rr][j].y) + (v[rr][j].z * v[rr][j].z + v[rr][j].w * v[rr][j].w); }
#pragma unroll
                for (int o = 1; o < 64; o <<= 1) { const float t0 = __shfl_xor(s1[0], o), t1 = __shfl_xor(s1[1], o); s1[0] += t0; s1[1] += t1; }
                const float r1a = rsqrtf(s1[0] * (1.f / D) + NORM_EPS), r1b = rsqrtf(s1[1] * (1.f / D) + NORM_EPS);
#pragma unroll
                for (int j = 0; j < 4; ++j) { const int k = 4 * F.lane + 256 * j;
                    const f32x4 g = *(const f32x4*)(g1p + k), ga = *(const f32x4*)(mb + 2048 + k);
#pragma unroll
                    for (int rr = 0; rr < 2; ++rr) { v[rr][j] = xnx[rr][j] + ga * (v[rr][j] * (rr ? r1b : r1a) * g);
                        s2[rr] += (v[rr][j].x * v[rr][j].x + v[rr][j].y * v[rr][j].y) + (v[rr][j].z * v[rr][j].z + v[rr][j].w * v[rr][j].w); } }
#pragma unroll
                for (int o = 1; o < 64; o <<= 1) { const float t0 = __shfl_xor(s2[0], o), t1 = __shfl_xor(s2[1], o); s2[0] += t0; s2[1] += t1; }
                const float r2a = rsqrtf(s2[0] * (1.f / D) + NORM_EPS), r2b = rsqrtf(s2[1] * (1.f / D) + NORM_EPS);
#pragma unroll
                for (int rr = 0; rr < 2; ++rr) { const int lr = 2 * F.wave + rr, m = m0 + lr; const float rstd2 = rr ? r2b : r2a;
                    GAS v2u* x1o = (GAS v2u*)(X1 + (size_t)m * D) + F.lane;
                    GAS v2u* h2o = (GAS v2u*)(H2 + (size_t)m * D) + F.lane;
#pragma unroll
                    for (int j = 0; j < 4; ++j) { const int k = 4 * F.lane + 256 * j;
                        { v2u o; o.x = cvtpk_s(v[rr][j].x, v[rr][j].y); o.y = cvtpk_s(v[rr][j].z, v[rr][j].w); __builtin_nontemporal_store(o, &x1o[64 * j]); }
                        const f32x4 g = *(const f32x4*)(g2 + k), sh = *(const f32x4*)(mb + 3072 + k), sc = *(const f32x4*)(mb + 4096 + k);
                        const f32x4 hv = v[rr][j] * rstd2 * g * (sc + 1.0f) + sh;
                        v2u hh; hh.x = cvtpk_s(hv.x, hv.y); hh.y = cvtpk_s(hv.z, hv.w); h2o[64 * j] = hh;
                        const f32x4 lo = hv - (f32x4){bflo(hh.x), bfhi(hh.x), bflo(hh.y), bfhi(hh.y)};
                        v2u ll; ll.x = cvtpk_s(lo.x, lo.y); ll.y = cvtpk_s(lo.z, lo.w);
                        *(LAS v2u*)(Ahi + lr * APITCH + 2 * k) = hh; *(LAS v2u*)(Alo + lr * APITCH + 2 * k) = ll; } }
            }
            bf16x8 rbl[4][3];
#pragma unroll
            for (int ks = 0; ks < 4; ++ks)
#pragma unroll
                for (int nt = 0; nt < 3; ++nt) rbl[ks][nt] = *(const GAS bf16x8*)(WrT + 48 * 1024 + (size_t)(16 * nt + r16) * 1024 + 128 * F.wave + 32 * ks + 8 * q4);
            if (grp + F.G < ngrp) P6_FETCH(grp + F.G);
            __syncthreads();
            {
                f32x4 acc[3];
#pragma unroll
                for (int nt = 0; nt < 3; ++nt) acc[nt] = (f32x4){0.f, 0.f, 0.f, 0.f};
#pragma unroll
                for (int ks = 0; ks < 4; ++ks) { const int k0 = 128 * F.wave + 32 * ks + 8 * q4;
                    const bf16x8 ah = *(const LAS bf16x8*)(Ahi + r16 * APITCH + 2 * k0), al = *(const LAS bf16x8*)(Alo + r16 * APITCH + 2 * k0);
#pragma unroll
                    for (int nt = 0; nt < 3; ++nt) { const bf16x8 bh = rbh[ks][nt], bl = rbl[ks][nt];
                        acc[nt] = __builtin_amdgcn_mfma_f32_16x16x32_bf16(ah, bh, acc[nt], 0, 0, 0);
                        acc[nt] = __builtin_amdgcn_mfma_f32_16x16x32_bf16(al, bh, acc[nt], 0, 0, 0);
                        acc[nt] = __builtin_amdgcn_mfma_f32_16x16x32_bf16(ah, bl, acc[nt], 0, 0, 0); } }
#pragma unroll
                for (int nt = 0; nt < 3; ++nt)
#pragma unroll
                    for (int r = 0; r < 4; ++r) part[(F.wave * 16 + 4 * q4 + r) * 48 + 16 * nt + r16] = acc[nt][r];
            }
            __syncthreads();
            for (int i = F.tid; i < 16 * 48; i += 512) { float t = 0.f;
#pragma unroll
                for (int w8 = 0; w8 < 8; ++w8) t += part[w8 * 16 * 48 + i];
                red[i] = t; }
            __syncthreads();
            if (F.wave == 0) {
                if (F.lane < 16) {
                    const LAS float* rl = red + F.lane * 48;
                    float gl[4];
#pragma unroll
                    for (int i = 0; i < 4; ++i) gl[i] = rl[i] + brg[i];
                    int gi = 0; float gm = gl[0];
#pragma unroll
                    for (int i = 1; i < 4; ++i) if (gl[i] > gm) { gm = gl[i]; gi = i; }
                    float gs = 0.f;
#pragma unroll
                    for (int i = 0; i < 4; ++i) gs += __expf(gl[i] - gm);
                    const float gwt = 1.0f / gs;
                    float el[8];
#pragma unroll
                    for (int i = 0; i < 8; ++i) el[i] = rl[4 + gi * 8 + i] + bre[gi * 8 + i];
                    int i1 = 0; float m1 = el[0];
#pragma unroll
                    for (int i = 1; i < 8; ++i) if (el[i] > m1) { m1 = el[i]; i1 = i; }
                    int i2 = -1; float m2 = -3.0e38f;
#pragma unroll
                    for (int i = 0; i < 8; ++i) if (i != i1 && el[i] > m2) { m2 = el[i]; i2 = i; }
                    const float rq = __expf(m2 - m1), w1 = 1.0f / (1.0f + rq), w2 = rq * w1;
                    const int tgt = 16 * (nstep & 3) + F.lane;
                    red[16 * 48 + tgt * 5 + 0] = __builtin_bit_cast(float, m0 + F.lane); red[16 * 48 + tgt * 5 + 1] = __builtin_bit_cast(float, gi * 8 + i1); red[16 * 48 + tgt * 5 + 2] = __builtin_bit_cast(float, gi * 8 + i2);
                    red[16 * 48 + tgt * 5 + 3] = gwt * w1; red[16 * 48 + tgt * 5 + 4] = gwt * w2;
                }
                ++nstep;
                const bool lastgrp = (grp + F.G >= ngrp);
                if ((nstep & 3) == 0 || lastgrp) {
                    LDS_WAIT(); asm volatile("" ::: "memory");
                    const int nval = ((nstep & 3) == 0) ? 64 : 16 * (nstep & 3);
                    const bool valid = F.lane < nval;
                    const LAS float* pr = red + 16 * 48 + F.lane * 5;
                    my_m = valid ? __builtin_bit_cast(int, pr[0]) : -1; my_e1 = valid ? __builtin_bit_cast(int, pr[1]) : 0; my_e2 = valid ? __builtin_bit_cast(int, pr[2]) : 0;
                    my_w1 = __builtin_bit_cast(int, pr[3]); my_w2 = __builtin_bit_cast(int, pr[4]);
                    const unsigned long long lt = (1ull << F.lane) - 1ull;
                    int r1 = 0, r2 = 0, ncnt = 0;
                    for (int e = 0; e < NEXP; ++e) {
                        const unsigned long long m1b = __ballot(valid && my_e1 == e), m2b = __ballot(valid && my_e2 == e);
                        const int c1 = __popcll(m1b), c2 = __popcll(m2b);
                        if (my_e1 == e) r1 = __popcll(m1b & lt);
                        if (my_e2 == e) r2 = c1 + __popcll(m2b & lt);
                        if (F.lane == e) ncnt = c1 + c2;
                    }
                    int base = 0;
                    if (F.lane < NEXP && ncnt > 0) base = (int)__hip_atomic_fetch_add(ecnt + F.lane, (unsigned)ncnt, __ATOMIC_RELAXED, __HIP_MEMORY_SCOPE_AGENT);
                    const int b1 = __shfl(base, my_e1), b2 = __shfl(base, my_e2);
                    if (valid) { list2[(size_t)my_e1 * M + b1 + r1] = (v2i){my_m * 2, my_w1}; list2[(size_t)my_e2 * M + b2 + r2] = (v2i){my_m * 2 + 1, my_w2};
                        tokpos[(size_t)my_m * 2] = (v2i){(my_e1 << 20) | (b1 + r1), my_w1}; tokpos[(size_t)my_m * 2 + 1] = (v2i){(my_e2 << 20) | (b2 + r2), my_w2}; }
                    if ((nstep & 3) != 0) nstep = (nstep + 3) & ~3;
                }
            }
        }
#undef P6_FETCH
        if (BOTH(6)) GRID_BAR();
    }

    LAS int* pref = (LAS int*)(F.lds + TAB_OFF); LAS int* cntl = pref + 40; LAS int* utab = (LAS int*)(F.lds + TAB_OFF + 512);
    if (IN(7) || IN(8)) {
        __syncthreads();
        if (F.tid < NEXP) cntl[F.tid] = (int)__hip_atomic_load(ecnt + F.tid, RLX_AGENT);
        __syncthreads();
        if (F.tid == 0) { int p = 0; for (int e = 0; e < NEXP; ++e) { pref[e] = p; p += (cntl[e] + 255) >> 8; } pref[NEXP] = p; }
        __syncthreads();
    }
    if (IN(7)) _Pragma("unroll") for (int rep_ = 0; rep_ < REPS(7); ++rep_) {
        F.lane = lane_id_v(); F.tid = F.wave * 64 + F.lane;
        const int U7 = pref[NEXP] * 2, RM7 = FLOWSEAM ? U7 / F.G : (1 << 20);
        pg8::GroupOrder S{pref, cntl, 2, F.G, F.vcu, M, 0, 1 << 20, F.G, RM7, nullptr, 0, 0, 0};
        { pg8::Unit u; for (int j = 0; j < 8 && S.next(j, u); ++j) { if (F.tid < 256) utab[j * 256 + F.tid] = (F.tid < u.nvalid) ? (list2[(size_t)u.lb + F.tid].x >> 1) : 0; } }
        __syncthreads();
        pg8::GatherProb P{(const char*)H2, (const char*)Wgu_t, D, utab};
        pg8::EpiGateUp E{ACT, F.lds + CS_OFF + F.wave * 2048};
        pg8::gemm_phase2<pg8::GatherProb, pg8::EpiGateUp, pg8::GroupOrder, true, true>(F.lds + RING_OFF, P, S, E, F.wave);
        if (BOTH(7)) GRID_BAR();
    }

    if (IN(8)) _Pragma("unroll") for (int rep_ = 0; rep_ < REPS(8); ++rep_) {
        F.lane = lane_id_v(); F.tid = F.wave * 64 + F.lane;
        const int U7 = pref[NEXP] * 2, RM7 = FLOWSEAM ? U7 / F.G : (1 << 20), TC7 = FLOWSEAM ? U7 - RM7 * F.G : 0;
        unsigned* flow = (unsigned*)(F.ctl + CW_FLOW);
        if (FLOWSEAM && F.vcu < TC7) {
            pg8::GroupOrder S{pref, cntl, 2, F.G, F.vcu, M, RM7 * F.G, 1 << 20, F.G, 1, flow, 1, 0, 0};
            { pg8::Unit u; if (S.next(0, u)) { if (F.tid < 256) utab[F.tid] = (F.tid < u.nvalid) ? (list2[(size_t)u.lb + F.tid].x >> 1) : 0; } }
            __syncthreads();
            pg8::GatherProb P{(const char*)H2, (const char*)Wgu_t, D, utab};
            pg8::EpiGateUp E{ACT, F.lds + CS_OFF + F.wave * 2048};
            pg8::gemm_phase2<pg8::GatherProb, pg8::EpiGateUp, pg8::GroupOrder, true, true>(F.lds + RING_OFF, P, S, E, F.wave);
        }
        const int U8 = pref[NEXP] * 4, R8 = (U8 + F.G - 1) / F.G; const bool drop = TC7 > 0 && TC7 * 4 <= F.G;
        const int c2 = (F.vcu - TC7 + F.G) % F.G;
        pg8::GroupOrder S{pref, cntl, 4, F.G, c2, M, 0, drop ? (R8 > 3 ? R8 - 3 : 0) : (1 << 20), F.G - TC7, 1 << 20, flow, TC7 > 0 ? 2 : 0, 2, (RM7 * F.G) / 2};
        pg8::DownProb P{(const char*)ACT, (const char*)Wd_t, FF};
        pg8::EpiFp8 E{Y8, F.lds + CS_OFF + F.wave * 2048};
        pg8::gemm_phase2<pg8::DownProb, pg8::EpiFp8, pg8::GroupOrder, true, true>(F.lds + RING_OFF, P, S, E, F.wave);
        if (BOTH(8)) GRID_BAR();
    }

    if (IN(9)) _Pragma("unroll") for (int rep_ = 0; rep_ < REPS(9); ++rep_) {
        F.lane = lane_id_v(); F.tid = F.wave * 64 + F.lane;
        if (!IN(7) && !IN(8)) {
            __syncthreads();
            if (F.tid < NEXP) cntl[F.tid] = (int)__hip_atomic_load(ecnt + F.tid, RLX_AGENT);
            __syncthreads();
            if (F.tid == 0) { int p = 0; for (int e = 0; e < NEXP; ++e) { pref[e] = p; p += (cntl[e] + 255) >> 8; } pref[NEXP] = p; }
            __syncthreads();
        }
        const float* g4 = args.in[5];
        unsigned yn0[4], yn1[4]; v2u xn[4]; float wn0 = 0.f, wn1 = 0.f;
        v2i tp0 = (v2i){0, 0}, tp1 = tp0;
#define P9_TOK(mm) do { tp0 = tokpos[(size_t)(mm) * 2]; tp1 = tokpos[(size_t)(mm) * 2 + 1]; } while (0)
#define P9_FETCH(mm) do { const int wb0_ = tp0.y, wb1_ = tp1.y; \
            wn0 = __builtin_bit_cast(float, wb0_) * 0.0625f; wn1 = __builtin_bit_cast(float, wb1_) * 0.0625f; \
            const size_t r0_ = (size_t)pref[tp0.x >> 20] * 256 + (tp0.x & 0xfffff), r1_ = (size_t)pref[tp1.x >> 20] * 256 + (tp1.x & 0xfffff); \
            const GAS unsigned* y0_ = (const GAS unsigned*)(Y8 + r0_ * 1024) + F.lane; const GAS unsigned* y1_ = (const GAS unsigned*)(Y8 + r1_ * 1024) + F.lane; const GAS v2u* x_ = (const GAS v2u*)(X1 + (size_t)(mm) * D) + F.lane; \
            _Pragma("unroll") for (int j = 0; j < 4; ++j) { yn0[j] = __builtin_nontemporal_load(&y0_[64 * j]); yn1[j] = __builtin_nontemporal_load(&y1_[64 * j]); xn[j] = __builtin_nontemporal_load(&x_[64 * j]); } } while (0)
        if (gw < M) { P9_TOK(gw); P9_FETCH(gw); }
        if (gw + NGW < M) P9_TOK(gw + NGW);
        for (int m = gw; m < M; m += NGW) {
            const int b = m / T; const float* mb = mod + b * 6144 + 5120;
            unsigned ya[4], yb[4]; v2u xu4[4]; const float w0 = wn0, w1 = wn1;
#pragma unroll
            for (int j = 0; j < 4; ++j) { ya[j] = yn0[j]; yb[j] = yn1[j]; xu4[j] = xn[j]; }
            if (m + NGW < M) P9_FETCH(m + NGW);
            if (m + 2 * NGW < M) P9_TOK(m + 2 * NGW);
            f32x4 v[4]; float s = 0.f;
#pragma unroll
            for (int j = 0; j < 4; ++j) { const int a = (int)ya[j], c = (int)yb[j];
                v[j] = (f32x4){__builtin_amdgcn_cvt_f32_fp8(a, 0), __builtin_amdgcn_cvt_f32_fp8(a, 1), __builtin_amdgcn_cvt_f32_fp8(a, 2), __builtin_amdgcn_cvt_f32_fp8(a, 3)} * w0
                     + (f32x4){__builtin_amdgcn_cvt_f32_fp8(c, 0), __builtin_amdgcn_cvt_f32_fp8(c, 1), __builtin_amdgcn_cvt_f32_fp8(c, 2), __builtin_amdgcn_cvt_f32_fp8(c, 3)} * w1;
                s += (v[j].x * v[j].x + v[j].y * v[j].y) + (v[j].z * v[j].z + v[j].w * v[j].w); }
            const float rstd = rsqrtf(wave_sum(s) * (1.f / D) + NORM_EPS);
            GAS f32x4* orow = (GAS f32x4*)(args.out + (size_t)m * D) + F.lane;
#pragma unroll
            for (int j = 0; j < 4; ++j) { const int k = 4 * F.lane + 256 * j; const v2u xu = xu4[j];
                const f32x4 x1v = (f32x4){bflo(xu.x), bfhi(xu.x), bflo(xu.y), bfhi(xu.y)};
                const f32x4 g = *(const f32x4*)(g4 + k), ga = *(const f32x4*)(mb + k);
                __builtin_nontemporal_store(x1v + ga * (v[j] * rstd * g), &orow[64 * j]); }
        }
#undef P9_FETCH
#undef P9_TOK
    }
#undef IN
#undef BOTH
}

extern "C" void kernel_launch(void* const* d_in, const int* in_sizes, int n_in, void* d_out, int out_size, void* d_ws, size_t ws_size, hipStream_t stream) {
    static int grid = 0;
    if (grid == 0) {
        if (n_in != 21 || in_sizes[0] != M * D || out_size != M * D || ws_size < WS_END) { fprintf(stderr, "kernel_launch: unexpected shapes (n_in %d, in0 %d, out %d, ws %zu)\n", n_in, n_in > 0 ? in_sizes[0] : -1, out_size, ws_size); grid = -1; return; }
        int dev = 0, cus = 0, per_cu = 0;
        if (hipGetDevice(&dev) != hipSuccess || hipDeviceGetAttribute(&cus, hipDeviceAttributeMultiprocessorCount, dev) != hipSuccess) { grid = -1; return; }
        if (hipFuncSetAttribute((const void*)fwd, hipFuncAttributeMaxDynamicSharedMemorySize, LDS_BYTES) != hipSuccess) { fprintf(stderr, "kernel_launch: hipFuncSetAttribute failed\n"); grid = -1; return; }
        if (hipOccupancyMaxActiveBlocksPerMultiprocessor(&per_cu, (const void*)fwd, NWAVES * 64, LDS_BYTES) != hipSuccess || per_cu < 1)
            fprintf(stderr, "kernel_launch: occupancy query reports %d workgroups per CU\n", per_cu);
        (void)hipGetLastError();
        grid = cus;
    }
    if (grid < 0) return;
    if (hipMemsetAsync((char*)d_ws + WS_CTL, 0, CTL_ZERO_BYTES, stream) != hipSuccess) return;
    Args a{};
    for (int i = 0; i < 21; ++i) a.in[i] = (const float*)d_in[i];
    a.out = (float*)d_out; a.ws = (unsigned char*)d_ws;
    if (N_LAUNCHES == 1) { a.ph_lo = 0; a.ph_hi = N_PHASES; hipLaunchKernelGGL(fwd, dim3(grid), dim3(NWAVES * 64), LDS_BYTES, stream, a); }
    else for (int li = 0; li < N_PHASES; ++li) { a.ph_lo = li; a.ph_hi = li + 1; hipLaunchKernelGGL(fwd, dim3(grid), dim3(NWAVES * 64), LDS_BYTES, stream, a); }
}
```
